# Optimizing an MI355X kernel written in HIP

```python
import jax, jax.numpy as jnp
from jax import lax
import numpy as np

D_MODEL = 1024
BATCH = 8
SEQ = 8192
DEPTH = 1
DEC_BATCH = 128
DEC_SEQ = 4
PAST_LEN = 8192
PAGE_SIZE = 128

D_MIX = D_MODEL
HEAD_DIM = 64
N_HEADS_A = (D_MIX // 2) // HEAD_DIM
D_A = N_HEADS_A * HEAD_DIM
D_B = D_MIX - D_A
CHUNK = 128
GROUP_B = 128
N_GROUPS_B = D_B // GROUP_B
D_FF = 2816
WINDOWS = (128, 512, 2048)
DILATIONS = (1, 4, 16)
W_MAX = max(WINDOWS)
ATTN_SCALE = HEAD_DIM ** -0.5
LN_EPS = 1e-5
NEG_INF = -1e30
DEEPNORM_ALPHA = (2.0 * DEPTH) ** 0.25
DEEPNORM_BETA = (8.0 * DEPTH) ** -0.25
FFN_HALF = 0.5

kernel_name = "hymba_longnet_gmlp_macaron_deepnorm_step"


def _layer_norm(x, g, b):
    xf = x.astype(jnp.float32)
    mu = xf.mean(-1, keepdims=True)
    var = jnp.square(xf - mu).mean(-1, keepdims=True)
    return ((xf - mu) * lax.rsqrt(var + LN_EPS) * g + b).astype(x.dtype)


def _rms_norm(x, g):
    xf = x.astype(jnp.float32)
    return (xf * lax.rsqrt(jnp.mean(xf * xf, -1, keepdims=True) + LN_EPS) * g).astype(x.dtype)


def _swiglu(x, w_in, w_out):
    gate, up = jnp.split(x @ w_in, 2, axis=-1)
    return (jax.nn.silu(gate) * up) @ w_out


def _attend_band(q, k, v, dilation, n_sub):
    B, S, H, Dh = q.shape
    span = dilation * n_sub
    L = -(-S // span) * span
    nb = L // span

    def blocks(t):
        t = jnp.pad(t.astype(jnp.float32), ((0, 0), (0, L - S), (0, 0), (0, 0)))
        return t.reshape(B, nb, n_sub, dilation, H, Dh)

    def with_prev(t):
        prev = jnp.concatenate([jnp.zeros_like(t[:, :1]), t[:, :-1]], axis=1)
        return jnp.concatenate([prev, t], axis=2)

    qb = blocks(q)
    kk = with_prev(blocks(k))
    vv = with_prev(blocks(v))
    s = jnp.einsum('bnirhd,bnjrhd->bnrhij', qb, kk) * ATTN_SCALE
    i = jnp.arange(n_sub)[:, None]
    j = jnp.arange(2 * n_sub)[None, :]
    diff = i + n_sub - j
    band = (diff >= 0) & (diff <= n_sub)
    exists = (jnp.arange(nb)[:, None, None] > 0) | (j[None] >= n_sub)
    mask = band[None] & exists
    s = jnp.where(mask[None, :, None, None], s, NEG_INF)
    m = s.max(-1, keepdims=True)
    e = jnp.exp(s - m)
    denom = e.sum(-1)
    o = jnp.einsum('bnrhij,bnjrhd->bnirhd', e, vv) / denom.transpose(0, 1, 4, 2, 3)[..., None]
    lse = (m[..., 0] + jnp.log(denom)).transpose(0, 1, 4, 2, 3)
    return o.reshape(B, L, H, Dh)[:, :S], lse.reshape(B, L, H)[:, :S]


def _attend_gathered(q, k_all, v_all, dilation, n_sub):
    T = q.shape[1]
    w_buf = k_all.shape[1] - T
    dist = jnp.arange(n_sub + 1) * dilation
    idx = w_buf + jnp.arange(T)[:, None] - dist[None, :]
    valid = idx >= 0
    idx = jnp.maximum(idx, 0)
    kg = jnp.take(k_all, idx, axis=1).astype(jnp.float32)
    vg = jnp.take(v_all, idx, axis=1).astype(jnp.float32)
    s = jnp.einsum('bthd,btjhd->bthj', q.astype(jnp.float32), kg) * ATTN_SCALE
    s = jnp.where(valid[None, :, None, :], s, NEG_INF)
    m = s.max(-1, keepdims=True)
    e = jnp.exp(s - m)
    denom = e.sum(-1)
    o = jnp.einsum('bthj,btjhd->bthd', e, vg) / denom[..., None]
    return o, m[..., 0] + jnp.log(denom)


def _combine_by_denominator(outs, lses):
    w = jax.nn.softmax(jnp.stack(lses), axis=0)
    return jnp.sum(w[..., None] * jnp.stack(outs), axis=0)


def _spatial_gating(u, v, w_s, b_s, g_v, b_v):
    B, S, _ = v.shape
    vn = _layer_norm(v, g_v, b_v)
    L = -(-S // CHUNK) * CHUNK
    vc = jnp.pad(vn, ((0, 0), (0, L - S), (0, 0))).reshape(B, L // CHUNK, CHUNK, N_GROUPS_B, GROUP_B)
    causal = jnp.tril(jnp.ones((CHUNK, CHUNK), dtype=bool))
    w = jnp.where(causal[None], w_s, 0.0)
    mix = jnp.einsum('gij,bnjgc->bnigc', w, vc) + b_s.T[None, None, :, :, None]
    return u * mix.reshape(B, L, D_B)[:, :S], vn


def _layer(x, p, cache_k, cache_v):
    (ffn1_w_in, ffn1_w_out, ln1_g, ln1_b, w_in, sgu_w, sgu_b, sgu_v_g, sgu_v_b,
     out_a_g, out_b_g, w_out, ln2_g, ln2_b, ffn2_w_in, ffn2_w_out, ln3_g, ln3_b) = p
    Bx, S, _ = x.shape
    x = _layer_norm(DEEPNORM_ALPHA * x + FFN_HALF * _swiglu(x, ffn1_w_in, ffn1_w_out), ln1_g, ln1_b)
    h = x @ w_in
    q, k, v, u_b, v_b = jnp.split(h, [D_A, 2 * D_A, 3 * D_A, 3 * D_A + D_B], axis=-1)
    q = q.reshape(Bx, S, N_HEADS_A, HEAD_DIM)
    k = k.reshape(Bx, S, N_HEADS_A, HEAD_DIM)
    v = v.reshape(Bx, S, N_HEADS_A, HEAD_DIM)
    outs, lses = [], []
    if cache_k is None:
        for win, dil in zip(WINDOWS, DILATIONS):
            o, l = _attend_band(q, k, v, dil, win // dil)
            outs.append(o)
            lses.append(l)
        keep = min(W_MAX, S)
        k_state, v_state = k[:, S - keep:], v[:, S - keep:]
    else:
        k_all = jnp.concatenate([cache_k.astype(k.dtype), k], axis=1)
        v_all = jnp.concatenate([cache_v.astype(v.dtype), v], axis=1)
        for win, dil in zip(WINDOWS, DILATIONS):
            o, l = _attend_gathered(q, k_all, v_all, dil, win // dil)
            outs.append(o)
            lses.append(l)
        k_state, v_state = k_all[:, S:], v_all[:, S:]
    o_a = _combine_by_denominator(outs, lses).astype(x.dtype).reshape(Bx, S, D_A)
    o_b, vn = _spatial_gating(u_b, v_b, sgu_w, sgu_b, sgu_v_g, sgu_v_b)
    mixed = jnp.concatenate([_rms_norm(o_a, out_a_g), _rms_norm(o_b, out_b_g)], axis=-1) @ w_out
    x = _layer_norm(DEEPNORM_ALPHA * x + mixed, ln2_g, ln2_b)
    x = _layer_norm(DEEPNORM_ALPHA * x + FFN_HALF * _swiglu(x, ffn2_w_in, ffn2_w_out), ln3_g, ln3_b)
    return x, k_state, v_state, vn


def setup_inputs(seed: int = 0) -> dict:
    key = jax.random.key(seed)
    ks = jax.random.split(key, 24)
    f32 = jnp.float32
    w_buf = min(W_MAX, PAST_LEN)

    def nrm(k, shape, scale=1.0):
        return jax.random.normal(k, shape, f32) * scale

    return {
        "x_prompt": nrm(ks[0], (BATCH, SEQ, D_MODEL)),
        "x_sample": nrm(ks[1], (DEC_BATCH, DEC_SEQ, D_MODEL)),
        "cache_k": nrm(ks[2], (DEPTH, DEC_BATCH, w_buf, N_HEADS_A, HEAD_DIM)),
        "cache_v": nrm(ks[3], (DEPTH, DEC_BATCH, w_buf, N_HEADS_A, HEAD_DIM)),
        "ffn1_w_in": nrm(ks[4], (DEPTH, D_MODEL, 2 * D_FF), D_MODEL ** -0.5),
        "ffn1_w_out": nrm(ks[5], (DEPTH, D_FF, D_MODEL), DEEPNORM_BETA * D_FF ** -0.5),
        "ln1_g": 1.0 + nrm(ks[6], (DEPTH, D_MODEL), 0.01),
        "ln1_b": nrm(ks[7], (DEPTH, D_MODEL), 0.01),
        "w_in": nrm(ks[8], (DEPTH, D_MODEL, 3 * D_A + 2 * D_B), D_MODEL ** -0.5),
        "sgu_w": nrm(ks[9], (DEPTH, N_GROUPS_B, CHUNK, CHUNK), CHUNK ** -0.5),
        "sgu_b": 1.0 + nrm(ks[10], (DEPTH, N_GROUPS_B, CHUNK), 0.01),
        "sgu_v_g": 1.0 + nrm(ks[11], (DEPTH, D_B), 0.01),
        "sgu_v_b": nrm(ks[12], (DEPTH, D_B), 0.01),
        "out_a_g": 1.0 + nrm(ks[13], (DEPTH, D_A), 0.01),
        "out_b_g": 1.0 + nrm(ks[14], (DEPTH, D_B), 0.01),
        "w_out": nrm(ks[15], (DEPTH, D_MIX, D_MODEL), DEEPNORM_BETA * D_MIX ** -0.5),
        "ln2_g": 1.0 + nrm(ks[16], (DEPTH, D_MODEL), 0.01),
        "ln2_b": nrm(ks[17], (DEPTH, D_MODEL), 0.01),
        "ffn2_w_in": nrm(ks[18], (DEPTH, D_MODEL, 2 * D_FF), D_MODEL ** -0.5),
        "ffn2_w_out": nrm(ks[19], (DEPTH, D_FF, D_MODEL), DEEPNORM_BETA * D_FF ** -0.5),
        "ln3_g": 1.0 + nrm(ks[20], (DEPTH, D_MODEL), 0.01),
        "ln3_b": nrm(ks[21], (DEPTH, D_MODEL), 0.01),
    }


def reference(x_prompt, x_sample, cache_k, cache_v, ffn1_w_in, ffn1_w_out, ln1_g, ln1_b, w_in,
              sgu_w, sgu_b, sgu_v_g, sgu_v_b, out_a_g, out_b_g, w_out, ln2_g, ln2_b,
              ffn2_w_in, ffn2_w_out, ln3_g, ln3_b):
    params = (ffn1_w_in, ffn1_w_out, ln1_g, ln1_b, w_in, sgu_w, sgu_b, sgu_v_g, sgu_v_b,
              out_a_g, out_b_g, w_out, ln2_g, ln2_b, ffn2_w_in, ffn2_w_out, ln3_g, ln3_b)
    y_p, y_s = x_prompt, x_sample
    kp_list, vp_list, ks_list, vs_list, us_list = [], [], [], [], []
    for layer in range(DEPTH):
        p = tuple(a[layer] for a in params)
        y_p, kp, vp, _ = _layer(y_p, p, None, None)
        y_s, ksmp, vsmp, usmp = _layer(y_s, p, cache_k[layer], cache_v[layer])
        kp_list.append(kp)
        vp_list.append(vp)
        ks_list.append(ksmp)
        vs_list.append(vsmp)
        us_list.append(usmp)
    cache_k_prompt = jnp.stack(kp_list)
    cache_v_prompt = jnp.stack(vp_list)
    cache_k_sample = jnp.stack(ks_list)
    cache_v_sample = jnp.stack(vs_list)
    sgu_v_sample = jnp.stack(us_list)
    return (y_p, y_s, cache_k_prompt, cache_v_prompt, cache_k_sample, cache_v_sample, sgu_v_sample)
```

```cpp
#include <hip/hip_runtime.h>
#include <cstdio>
#include <cstdint>
namespace pg8 {
#define PG8_LAS __attribute__((address_space(3)))
typedef unsigned short bf16_t;
typedef short bf16x8 __attribute__((ext_vector_type(8)));
typedef float f32x4 __attribute__((ext_vector_type(4)));
typedef unsigned u32x4 __attribute__((ext_vector_type(4)));
typedef int v8i_t __attribute__((ext_vector_type(8)));
typedef int v4i_t __attribute__((ext_vector_type(4)));
constexpr int BM = 256, BK = 64, HALF = 128, HTB = HALF * BK * 2  , STAGE_BYTES = 8 * HTB, NXCD = 8, WGM = 8;

__host__ __device__ __forceinline__ int lds_byte(int r, int c) { const int st = (r >> 4) * 2 + (c >> 5), rr = r & 15, cc = c & 31, ob = rr * 64 + cc * 2; return st * 1024 + (ob ^ (((ob >> 9) & 1) << 5)); }
__host__ __device__ __forceinline__ void stage_rc(int b, int& R, int& C) { const int st = b / 1024, sb = b % 1024, swz = sb ^ (((sb >> 9) & 1) << 5); R = (st >> 1) * 16 + swz / 64; C = (st & 1) * 32 + (swz % 64) / 2; }
__host__ __device__ __forceinline__ int perm32(int rho) { const int n = rho >> 4, i = rho & 15; return 8 * (i >> 2) + 4 * n + (i & 3); }

struct Unit { int pm, pn; };
struct Gemm { const bf16_t* A; const bf16_t* Bt; int M, N, K; int atile, btile; };

struct StaticOrder {
    int nM, nN, nwg, G, c;
    __host__ __device__ void init(int M, int N, int G_, int c_) { nM = M / BM; nN = N / BM; nwg = nM * nN; G = G_; c = c_; }
    __host__ __device__ bool next(int i, Unit& u) const {
        const long L = (long)i * G + c; if (L >= nwg) return false;
        int wgid = (int)L; { const int q = nwg / NXCD, r = nwg % NXCD, xcd = wgid % NXCD, off = wgid / NXCD; wgid = (xcd < r ? xcd * (q + 1) : r * (q + 1) + (xcd - r) * q) + off; }
        const int nig = WGM * nN, gid = wgid / nig, fm = gid * WGM, gsz = (nM - fm) < WGM ? (nM - fm) : WGM;
        u.pm = fm + ((wgid % nig) % gsz); u.pn = (wgid % nig) / gsz; return true;
    }
    __device__ __forceinline__ void a_ready(const Unit&) const {}
    __device__ __forceinline__ void done(const Unit&) const {}
};
template <int KIND> struct SubsetOrder : StaticOrder {
    __host__ __device__ void init_sub(int N, int G_, int c_) { StaticOrder::init((KIND == 0 ? 128 : 130) * BM, N, G_, c_); }
    __host__ __device__ bool next(int i, Unit& u) const {
        if (!StaticOrder::next(i, u)) return false;
        const int v = u.pm; u.pm = (KIND == 0) ? ((v >> 4) * 32 + (v & 15)) : (v < 128 ? ((v >> 4) * 32 + 16 + (v & 15)) : (256 + (v - 128)));
        return true;
    }
};
template <int LO, int HI> struct RangeOrder : StaticOrder {
    __host__ __device__ void init_sub(int N, int G_, int c_) { StaticOrder::init((HI - LO) * 8 * BM, N, G_, c_); }
    __host__ __device__ bool next(int i, Unit& u) const {
        if (!StaticOrder::next(i, u)) return false;
        const int v = u.pm; u.pm = (v / (HI - LO)) * 32 + LO + (v % (HI - LO));
        return true;
    }
};
typedef float f32x2c_t __attribute__((ext_vector_type(2))); typedef __bf16 bf16x2c_t __attribute__((ext_vector_type(2)));
__device__ __forceinline__ unsigned cvt_pk_bf16(float lo, float hi) { const f32x2c_t v = {lo, hi}; const bf16x2c_t b = __builtin_convertvector(v, bf16x2c_t); return __builtin_bit_cast(unsigned, b); }
typedef float f32x2 __attribute__((ext_vector_type(2)));
typedef float f32x2v __attribute__((ext_vector_type(2)));
typedef unsigned u32x2v __attribute__((ext_vector_type(2)));
constexpr int MP = 65536, MS = 512, MTOT = MP + MS;
constexpr float LN_EPS = 1e-5f;
constexpr float DN_ALPHA = 1.189207115002721f;
constexpr float QSCALE = 0.125f * 1.4426950408889634f;

__device__ __forceinline__ void combine16(const float* st, float& mean, float& rstd) {
    f32x4 p[8];
#pragma unroll
    for (int i = 0; i < 8; ++i) p[i] = *(const f32x4*)(st + 4 * i);
    float ms = 0.f;
#pragma unroll
    for (int i = 0; i < 8; ++i) ms += p[i][0] + p[i][2];
    mean = ms * (1.0f / 16.0f);
    float q = 0.f;
#pragma unroll
    for (int i = 0; i < 8; ++i) { const float d0 = p[i][0] - mean, d1 = p[i][2] - mean; q += (p[i][1] + p[i][3]) + 64.0f * (d0 * d0 + d1 * d1); }
    rstd = 1.0f / sqrtf(q * (1.0f / 1024.0f) + LN_EPS);
}
__device__ __forceinline__ void lane_row_stats(const float* PR, int rowbase, int fr, int fq, float (&mean)[8], float (&rstd)[8]) {
#pragma unroll
    for (int k = 0; k < 8; ++k) { const f32x2v ab = *(const f32x2v*)(PR + 2 * (size_t)(rowbase + (k >> 2) * 128 + (k & 3) * 16)); mean[k] = ab.x; rstd[k] = ab.y; }
}
__device__ __forceinline__ void lane_row_stats4(const float* ST, int rowbase, int fr, int fq, float (&mean)[4], float (&rstd)[4]) {
    float m1, r1; combine16(ST + (size_t)(rowbase + fq * 16) * 32, m1, r1);
#pragma unroll
    for (int m = 0; m < 4; ++m) { mean[m] = __shfl(m1, fr + 16 * m); rstd[m] = __shfl(r1, fr + 16 * m); }
}
__device__ __forceinline__ unsigned pk4_fp8e(float a, float b, float c, float d) { int w = __builtin_amdgcn_cvt_pk_fp8_f32(a, b, 0, false); w = __builtin_amdgcn_cvt_pk_fp8_f32(c, d, w, true); return (unsigned)w; }
__device__ __forceinline__ float bf2f(unsigned short b) { return __uint_as_float((unsigned)b << 16); }
__device__ __forceinline__ float bflo(unsigned w) { return __uint_as_float(w << 16); }
__device__ __forceinline__ float bfhi(unsigned w) { return __uint_as_float(w & 0xffff0000u); }

typedef __amdgpu_buffer_rsrc_t rsrc_t;
__device__ __forceinline__ rsrc_t mk_rsrc(const void* p, unsigned bytes) { return __builtin_amdgcn_make_buffer_rsrc((void*)p, 0, bytes, 0x00020000); }
__device__ __forceinline__ u32x4 bload16(rsrc_t r, unsigned voff, unsigned soff) { return __builtin_bit_cast(u32x4, __builtin_amdgcn_raw_buffer_load_b128(r, voff, soff, 0)); }
__device__ __forceinline__ void bstore16(rsrc_t r, unsigned voff, unsigned soff, u32x4 v) { __builtin_amdgcn_raw_buffer_store_b128(v, r, voff, soff, 0); }
__device__ __forceinline__ void bstore16f(rsrc_t r, unsigned voff, unsigned soff, f32x4 v) { __builtin_amdgcn_raw_buffer_store_b128(__builtin_bit_cast(u32x4, v), r, voff, soff, 0); }
__device__ __forceinline__ void bstore8f(rsrc_t r, unsigned voff, unsigned soff, f32x2v v) { __builtin_amdgcn_raw_buffer_store_b64(__builtin_bit_cast(u32x2v, v), r, voff, soff, 0); }

template <int MODE, bool STATS> struct EpiRes {
    static constexpr bool PERM = true, AFTER_DRAIN = false;
    const bf16_t* rsrc; const float* stprev; const float* g; const float* b; bf16_t* zb; float* stout; float scale;
    __device__ __forceinline__ void operator()(const f32x4 (&acc)[2][2][4][2], const Unit& u, int wr, int wc, int fr_in, int fq_in) const {
        int fr = fr_in, fq = fq_in; asm volatile("" : "+v"(fr), "+v"(fq));
        const int rowU = u.pm * BM + wr * 64, colU = u.pn * BM + wc * 32;
        const unsigned voff = (unsigned)(fr * 1024 + 8 * fq) * 2u;
        const unsigned sbase = (unsigned)(rowU * 1024 + colU) * 2u;
        const rsrc_t rR = (MODE == 2) ? mk_rsrc((const float*)rsrc + (size_t)(u.pm >> 5) * (8192 * 1024), 8192u * 4096u) : mk_rsrc(rsrc, (unsigned)MTOT * 2048u);
        const rsrc_t rZ = mk_rsrc(zb, (unsigned)MTOT * 2048u), rS = mk_rsrc(stout, (unsigned)MTOT * 128u);
        const unsigned sbase4 = (unsigned)(((u.pm & 31) * BM + wr * 64) * 1024 + colU) * 4u;
        float mean[8], rstd[8]; f32x4 gv[2][2], bv[2][2];
        if (MODE == 1) {
            lane_row_stats(stprev, rowU + fr, fr, fq, mean, rstd);
#pragma unroll
            for (int bj = 0; bj < 2; ++bj)
#pragma unroll
                for (int n = 0; n < 2; ++n) { gv[bj][n] = *(const f32x4*)(g + colU + bj * HALF + 4 * n + 8 * fq); bv[bj][n] = *(const f32x4*)(b + colU + bj * HALF + 4 * n + 8 * fq); }
        }
#pragma unroll
        for (int ai = 0; ai < 2; ++ai)
#pragma unroll
            for (int m = 0; m < 4; ++m) {
                const int k = ai * 4 + m; const unsigned so = sbase + (unsigned)((ai * HALF + m * 16) * 1024) * 2u;
                u32x4 raw[2], raw2[2];
                if (MODE == 2) { const unsigned so4 = sbase4 + (unsigned)((ai * HALF + m * 16) * 1024) * 4u;
#pragma unroll
                    for (int bj = 0; bj < 2; ++bj) { raw[bj] = bload16(rR, 2u * voff, so4 + bj * (HALF * 4)); raw2[bj] = bload16(rR, 2u * voff, so4 + bj * (HALF * 4) + 16u); } }
                else {
#pragma unroll
                for (int bj = 0; bj < 2; ++bj) raw[bj] = bload16(rR, voff, so + bj * (HALF * 2));
                }
                f32x4 z[2][2]; float s = 0.f;
#pragma unroll
                for (int bj = 0; bj < 2; ++bj) {
                    const u32x4 w = raw[bj];
                    f32x4 r0 = (f32x4){bflo(w.x), bfhi(w.x), bflo(w.y), bfhi(w.y)}, r1 = (f32x4){bflo(w.z), bfhi(w.z), bflo(w.w), bfhi(w.w)};
                    if (MODE == 2) { r0 = __builtin_bit_cast(f32x4, raw[bj]); r1 = __builtin_bit_cast(f32x4, raw2[bj]); }
                    if (MODE == 1) { r0 = (r0 - mean[k]) * rstd[k] * gv[bj][0] + bv[bj][0]; r1 = (r1 - mean[k]) * rstd[k] * gv[bj][1] + bv[bj][1]; }
                    z[bj][0] = r0 * DN_ALPHA + acc[ai][bj][m][0] * scale; z[bj][1] = r1 * DN_ALPHA + acc[ai][bj][m][1] * scale;
                    s += ((z[bj][0][0] + z[bj][0][1]) + (z[bj][0][2] + z[bj][0][3])) + ((z[bj][1][0] + z[bj][1][1]) + (z[bj][1][2] + z[bj][1][3]));
                }
                if (STATS) {
                    s += __shfl_xor(s, 16); s += __shfl_xor(s, 32);
                    const float mw = s * (1.0f / 64.0f); float q = 0.f;
#pragma unroll
                    for (int bj = 0; bj < 2; ++bj)
#pragma unroll
                        for (int n = 0; n < 2; ++n) { const f32x4 d = z[bj][n] - mw; q += (d[0] * d[0] + d[1] * d[1]) + (d[2] * d[2] + d[3] * d[3]); }
                    q += __shfl_xor(q, 16); q += __shfl_xor(q, 32);
                    if (fq == 0) bstore8f(rS, (unsigned)fr * 128u, (unsigned)((rowU + ai * HALF + m * 16) * 32 + (u.pn * 4 + wc) * 2) * 4u, (f32x2v){mw, q});
                }
#pragma unroll
                for (int bj = 0; bj < 2; ++bj) {
                    u32x4 w; w.x = cvt_pk_bf16(z[bj][0][0], z[bj][0][1]); w.y = cvt_pk_bf16(z[bj][0][2], z[bj][0][3]); w.z = cvt_pk_bf16(z[bj][1][0], z[bj][1][1]); w.w = cvt_pk_bf16(z[bj][1][2], z[bj][1][3]);
                    bstore16(rZ, voff, so + bj * (HALF * 2), w);
                }
                asm volatile("" ::: "memory");
            }
    }
};

template <bool FOLD, bool I8IN = false> struct EpiSwiGLU {
    static constexpr bool PERM = true, AFTER_DRAIN = false;
    bf16_t* H; const float* st; const float* svec; const float* tvec; unsigned char* H8; int f8p; const float* xs; const float* wsc;
    __device__ __forceinline__ void operator()(const f32x4 (&acc)[2][2][4][2], const Unit& u, int wr, int wc, int fr, int fq) const {
        const int rowU = u.pm * BM + wr * 64, rhoU = u.pn * BM + wc * 32, hcolU = u.pn * HALF + wc * 32;
        const bool f8o = (H8 != nullptr) && (u.pm < 256) && ((u.pm & 31) < f8p);
        unsigned char* h8b = H8 + (size_t)u.pm * (BM * 2816) + (size_t)u.pn * (BM * 128) + (wr * 64) * 128 + wc * 32;
        const unsigned loff = (unsigned)(fr * 64 + 8 * fq);
        float mean[8], rstd[8]; f32x4 sv[2][2], tv[2][2];
        if (FOLD) {
            if (!I8IN) lane_row_stats(st, rowU + fr, fr, fq, mean, rstd);
#pragma unroll
            for (int bj = 0; bj < 2; ++bj)
#pragma unroll
                for (int n = 0; n < 2; ++n) { if (!I8IN) sv[bj][n] = *(const f32x4*)(svec + rhoU + bj * HALF + 4 * n + 8 * fq); tv[bj][n] = *(const f32x4*)(tvec + rhoU + bj * HALF + 4 * n + 8 * fq); }
        }
        float xr[8]; f32x4 wq[2][2];
        if (I8IN && FOLD) {
#pragma unroll
            for (int k8 = 0; k8 < 8; ++k8) xr[k8] = xs[2 * (size_t)(rowU + (k8 >> 2) * HALF + (k8 & 3) * 16 + fr)];
        }
        if (I8IN) {
            if (!FOLD) {
#pragma unroll
            for (int k8 = 0; k8 < 8; ++k8) xr[k8] = xs[rowU + (k8 >> 2) * HALF + (k8 & 3) * 16 + fr];
            }
#pragma unroll
            for (int bj = 0; bj < 2; ++bj)
#pragma unroll
                for (int n = 0; n < 2; ++n) wq[bj][n] = *(const f32x4*)(wsc + rhoU + bj * HALF + 4 * n + 8 * fq);
        }
        bf16_t* hb = H + (size_t)u.pm * (BM * 2816) + (size_t)(hcolU >> 6) * (BM * 64) + (wr * 64) * 64 + (hcolU & 63);
#pragma unroll
        for (int ai = 0; ai < 2; ++ai)
#pragma unroll
            for (int m = 0; m < 4; ++m) {
                const int k = ai * 4 + m;
                float hv[8];
#pragma unroll
                for (int n = 0; n < 2; ++n) {
                    f32x4 gt = acc[ai][0][m][n], up = acc[ai][1][m][n];
                    if (I8IN) { const v4i_t gi = __builtin_bit_cast(v4i_t, gt), ui = __builtin_bit_cast(v4i_t, up);
                        gt = (f32x4){(float)gi[0], (float)gi[1], (float)gi[2], (float)gi[3]} * xr[k] * wq[0][n]; up = (f32x4){(float)ui[0], (float)ui[1], (float)ui[2], (float)ui[3]} * xr[k] * wq[1][n]; }
                    if (FOLD && I8IN) { gt = gt + tv[0][n]; up = up + tv[1][n]; }
                    else if (FOLD) { gt = (gt - sv[0][n] * mean[k]) * rstd[k] + tv[0][n]; up = (up - sv[1][n] * mean[k]) * rstd[k] + tv[1][n]; }
#pragma unroll
                    for (int e = 0; e < 4; ++e) { const float sg = __builtin_amdgcn_rcpf(1.0f + __builtin_amdgcn_exp2f(gt[e] * -1.4426950408889634f)); hv[4 * n + e] = gt[e] * sg * up[e]; }
                }
                if (f8o) { u32x2v q; q.x = pk4_fp8e(hv[0], hv[1], hv[2], hv[3]); q.y = pk4_fp8e(hv[4], hv[5], hv[6], hv[7]);
                    __builtin_nontemporal_store(q, (u32x2v*)(h8b + (size_t)(ai * HALF + m * 16) * 128 + (unsigned)(fr * 128 + 8 * fq))); }
                else {
                u32x4 w; w.x = cvt_pk_bf16(hv[0], hv[1]); w.y = cvt_pk_bf16(hv[2], hv[3]); w.z = cvt_pk_bf16(hv[4], hv[5]); w.w = cvt_pk_bf16(hv[6], hv[7]);
                __builtin_nontemporal_store(w, (u32x4*)(hb + (size_t)(ai * HALF + m * 16) * 64 + loff)); }
                asm volatile("" ::: "memory");
            }
    }
};

struct EpiQKV {
    static constexpr bool PERM = true, AFTER_DRAIN = false;
    bf16_t* qkv; const float* st; const float* svec; const float* tvec; float* ckp; float* cvp; float* cks; float* cvs;
    __device__ __forceinline__ void operator()(const f32x4 (&acc)[2][2][4][2], const Unit& u, int wr, int wc, int fr, int fq) const {
        const int rowU = u.pm * BM + wr * 64, rhoU = u.pn * BM + wc * 32;
        const int tsel = u.pn >> 1, dcolU = (u.pn & 1) * BM + wc * 32;
        bf16_t* dstU = qkv + (size_t)tsel * ((size_t)MTOT * 512) + (size_t)rowU * 512 + dcolU;
        const unsigned loff = (unsigned)(fr * 512 + 8 * fq);
        const float sc = (tsel == 0) ? QSCALE : 1.0f;
        float mean[8], rstd[8];
        lane_row_stats(st, rowU + fr, fr, fq, mean, rstd);
        int cmode = 0; float* cU = nullptr; size_t SA = 0, SM = 0; unsigned coffL = 0;
        if (tsel == 1 || tsel == 2) {
            if (u.pm < 256) { if ((u.pm & 31) >= 24) { cmode = 1; cU = ((tsel == 1) ? ckp : cvp) + ((size_t)(u.pm >> 5) * 2048 + (size_t)((u.pm & 31) - 24) * 256 + wr * 64) * 512 + dcolU; SA = (size_t)HALF * 512; SM = (size_t)16 * 512; coffL = (unsigned)(fr * 512 + 8 * fq); } }
            else { cmode = 2; cU = ((tsel == 1) ? cks : cvs) + ((size_t)((u.pm - 256) * 64 + wr * 16) * 2048 + 2044) * 512 + dcolU; SA = (size_t)32 * 2048 * 512; SM = (size_t)4 * 2048 * 512; coffL = (unsigned)(((fr >> 2) * 2048 + (fr & 3)) * 512 + 8 * fq); }
        }
        f32x4 sv[2][2], tv[2][2];
#pragma unroll
        for (int bj = 0; bj < 2; ++bj)
#pragma unroll
            for (int n = 0; n < 2; ++n) { sv[bj][n] = *(const f32x4*)(svec + rhoU + bj * HALF + 4 * n + 8 * fq); tv[bj][n] = *(const f32x4*)(tvec + rhoU + bj * HALF + 4 * n + 8 * fq); }
#pragma unroll
        for (int ai = 0; ai < 2; ++ai)
#pragma unroll
            for (int m = 0; m < 4; ++m) {
                const int k = ai * 4 + m;
                bf16_t* drow = dstU + (size_t)(ai * HALF + m * 16) * 512;
                float* crow = cU + ai * SA + m * SM;
#pragma unroll
                for (int bj = 0; bj < 2; ++bj) {
                    f32x4 v0 = (acc[ai][bj][m][0] - sv[bj][0] * mean[k]) * rstd[k] + tv[bj][0];
                    f32x4 v1 = (acc[ai][bj][m][1] - sv[bj][1] * mean[k]) * rstd[k] + tv[bj][1];
                    if (cmode != 0) { *(f32x4*)(crow + bj * HALF + coffL) = v0; *(f32x4*)(crow + bj * HALF + 4 + coffL) = v1; }
                    v0 = v0 * sc; v1 = v1 * sc;
                    u32x4 w; w.x = cvt_pk_bf16(v0[0], v0[1]); w.y = cvt_pk_bf16(v0[2], v0[3]); w.z = cvt_pk_bf16(v1[0], v1[1]); w.w = cvt_pk_bf16(v1[2], v1[3]);
                    if (tsel >= 3) __builtin_nontemporal_store(w, (u32x4*)(drow + bj * HALF + loff)); else *(u32x4*)(drow + bj * HALF + loff) = w;
                }
                asm volatile("" ::: "memory");
            }
    }
};
struct NoHook { static constexpr int EXTRA = 0; __device__ __forceinline__ void prime() {} __device__ __forceinline__ void ld() {} __device__ __forceinline__ void rd() {} __device__ __forceinline__ void wr() {} __device__ __forceinline__ void flush() {} };
template <class Epi, class Sched, bool ALIGN_EPI = false, bool SP2 = false, class HK = NoHook, int QM = 0>
__device__ __forceinline__ void gemm_phase(PG8_LAS unsigned char* lds, const Gemm g, const Sched& S, const Epi& E, HK& hk) {
    static_assert(HK::EXTRA == 0 || ((HK::EXTRA == 4 || HK::EXTRA == 2) && SP2), "side stream: 0, 2 or 4 operations per trip, SP2 loop only");
    int tid_l = threadIdx.x; asm volatile("" : "+v"(tid_l));
    const int tid = tid_l, wid = __builtin_amdgcn_readfirstlane(tid >> 6), lane = tid & 63, wr = wid >> 2, wc = wid & 3, fr = lane & 15, fq = lane >> 4;
    const int K = g.K, nt = K / BK;
    unsigned voffA[2], voffB[2];
#pragma unroll
    for (int i = 0; i < 2; ++i) { int R, C; stage_rc(tid * 16 + i * 8192, R, C); const int Rb = Epi::PERM ? ((R & ~31) + perm32(R & 31)) : R;
        voffA[i] = (unsigned)(R * (g.atile ? BK : K) + C) * 2u; voffB[i] = (unsigned)(Rb * (g.btile ? BK : K) + C) * 2u; }
    const size_t kstep = (size_t)(BK * 2);
    const size_t hstep = (size_t)HALF * K * 2;
    const size_t tstep = 2 * hstep;
    const size_t kstepA = g.atile ? (size_t)(BM * BK * 2) : kstep, hstepA = g.atile ? (size_t)(HALF * BK * 2) : hstep;
    const size_t kstepB = g.btile ? (size_t)(BM * BK * 2) : kstep, hstepB = g.btile ? (size_t)(HALF * BK * 2) : hstep;
    const unsigned ldsw = (unsigned)wid * 1024u;
    const int aoff = lds_byte(wr * 64 + fr, fq * 8), boff = lds_byte(wc * 32 + fr, fq * 8);
#define PG8_SA(b, h) (((b) * 2 + (h)) * HTB)
#define PG8_SB(b, h) ((4 + (b) * 2 + (h)) * HTB)
#define PG8_STAGE(bufoff, gbase, voff) do { _Pragma("unroll") for (int _i = 0; _i < 2; ++_i) \
        __builtin_amdgcn_global_load_lds((const unsigned*)((const char*)(gbase) + (voff)[_i]), (PG8_LAS unsigned*)(lds + (bufoff) + ldsw + _i * 8192), 16, 0, 0); } while (0)
#define PG8_LDA(dst, b, h) do { _Pragma("unroll") for (int m = 0; m < 4; ++m) _Pragma("unroll") for (int k = 0; k < 2; ++k) dst[m][k] = *(const PG8_LAS bf16x8*)(lds + PG8_SA(b, h) + aoff + m * 2048 + k * 1024); } while (0)
#define PG8_LDB(dst, b, h) do { _Pragma("unroll") for (int n = 0; n < 2; ++n) _Pragma("unroll") for (int k = 0; k < 2; ++k) dst[n][k] = *(const PG8_LAS bf16x8*)(lds + PG8_SB(b, h) + boff + n * 2048 + k * 1024); } while (0)
#define PG8_CAT8(lo, hi) __builtin_shufflevector(__builtin_bit_cast(v4i_t, lo), __builtin_bit_cast(v4i_t, hi), 0, 1, 2, 3, 4, 5, 6, 7)
#define PG8_MMA(ai, bj, At, Bt) do { __builtin_amdgcn_s_setprio(1); if constexpr (QM == 1) { _Pragma("unroll") for (int m = 0; m < 4; ++m) _Pragma("unroll") for (int n = 0; n < 2; ++n) { \
        const v8i_t b8_ = PG8_CAT8(Bt[n][0], Bt[n][1]), a8_ = PG8_CAT8(At[m][0], At[m][1]); \
        asm volatile("v_mfma_scale_f32_16x16x128_f8f6f4 %0, %1, %2, %0, %3, %4 op_sel_hi:[0,0,0]" : "+v"(acc[ai][bj][m][n]) : "v"(b8_), "v"(a8_), "v"(f8_sw), "v"(f8_sx)); } } else if constexpr (QM == 2) { \
        _Pragma("unroll") for (int m = 0; m < 4; ++m) _Pragma("unroll") for (int n = 0; n < 2; ++n) _Pragma("unroll") for (int k = 0; k < 2; ++k) \
        acc[ai][bj][m][n] = __builtin_bit_cast(f32x4, __builtin_amdgcn_mfma_i32_16x16x64_i8(__builtin_bit_cast(v4i_t, Bt[n][k]), __builtin_bit_cast(v4i_t, At[m][k]), __builtin_bit_cast(v4i_t, acc[ai][bj][m][n]), 0, 0, 0)); } else { \
        _Pragma("unroll") for (int m = 0; m < 4; ++m) _Pragma("unroll") for (int n = 0; n < 2; ++n) _Pragma("unroll") for (int k = 0; k < 2; ++k) \
        acc[ai][bj][m][n] = __builtin_amdgcn_mfma_f32_16x16x32_bf16(Bt[n][k], At[m][k], acc[ai][bj][m][n], 0, 0, 0); } __builtin_amdgcn_s_setprio(0); } while (0)
#define PG8_WAIT_V(n) asm volatile("s_waitcnt vmcnt(" #n ")" ::: "memory")
#define PG8_WAIT_VX(n4, n2) do { if constexpr (HK::EXTRA == 4) PG8_WAIT_V(n4); else if constexpr (HK::EXTRA == 2) PG8_WAIT_V(n2); else PG8_WAIT_V(8); } while (0)
#define PG8_WAIT_L(n) asm volatile("s_waitcnt lgkmcnt(" #n ")" ::: "memory")
#define PG8_BAR __builtin_amdgcn_s_barrier()
#define PG8_SCHED __builtin_amdgcn_sched_barrier(0)
    const int f8_sw = 0x79797979, f8_sx = 0x7f7f7f7f;
    Unit cur, nxt; int ui = 0;
    if (!S.next(0, cur)) return;
    f32x4 acc[2][2][4][2];
#pragma unroll
    for (int a = 0; a < 2; ++a)
#pragma unroll
        for (int b = 0; b < 2; ++b)
#pragma unroll
            for (int m = 0; m < 4; ++m)
#pragma unroll
                for (int n = 0; n < 2; ++n) acc[a][b][m][n] = (f32x4){0.f, 0.f, 0.f, 0.f};
    bf16x8 At[4][2], B0[2][2], B1[2][2];
    const char* cA = (const char*)g.A + (size_t)cur.pm * tstep; const char* cB = (const char*)g.Bt + (size_t)cur.pn * tstep;
    S.a_ready(cur);
    if constexpr (SP2) {
        PG8_STAGE(PG8_SB(0, 0), cB, voffB); PG8_STAGE(PG8_SB(0, 1), cB + hstepB, voffB); PG8_STAGE(PG8_SA(0, 0), cA, voffA); PG8_STAGE(PG8_SA(0, 1), cA + hstepA, voffA);
        if (wr == 1) PG8_BAR;
        PG8_WAIT_V(2); PG8_BAR;
        PG8_STAGE(PG8_SB(1, 0), cB + kstepB, voffB); PG8_STAGE(PG8_SA(1, 0), cA + kstepA, voffA); PG8_STAGE(PG8_SB(1, 1), cB + hstepB + kstepB, voffB);
        PG8_WAIT_V(6); PG8_BAR;
    } else {
        PG8_STAGE(PG8_SB(0, 0), cB, voffB); PG8_STAGE(PG8_SA(0, 0), cA, voffA); PG8_STAGE(PG8_SB(0, 1), cB + hstepB, voffB); PG8_STAGE(PG8_SA(0, 1), cA + hstepA, voffA);
        if (wr == 1) PG8_BAR;
        PG8_WAIT_V(4); PG8_BAR;
        PG8_STAGE(PG8_SB(1, 0), cB + kstepB, voffB); PG8_STAGE(PG8_SA(1, 0), cA + kstepA, voffA); PG8_STAGE(PG8_SB(1, 1), cB + hstepB + kstepB, voffB);
        PG8_WAIT_V(6); PG8_BAR;
    }
    hk.prime();
    for (;;) {
        const bool has_next = S.next(ui + 1, nxt);
        const char* nA = has_next ? (const char*)g.A + (size_t)nxt.pm * tstep : cA; const char* nB = has_next ? (const char*)g.Bt + (size_t)nxt.pn * tstep : cB;
        for (int t = 0; t < nt; t += 2) {
            const bool last = (t == nt - 2);
            const char* a1 = cA + (size_t)(t + 1) * kstepA;
            const char* a2 = last ? nA : cA + (size_t)(t + 2) * kstepA; const char* b2 = last ? nB : cB + (size_t)(t + 2) * kstepB;
            const char* a3 = a2 + kstepA; const char* b3 = b2 + kstepB;
            if (last && has_next) S.a_ready(nxt);
            if constexpr (SP2) {
            PG8_LDB(B0, 0, 0); PG8_LDB(B1, 0, 1); PG8_SCHED; PG8_LDA(At, 0, 0); PG8_STAGE(PG8_SA(1, 1), a1 + hstepA, voffA);
            PG8_WAIT_VX(10, 9); PG8_WAIT_L(0); PG8_BAR; PG8_MMA(0, 0, At, B0); hk.ld(); PG8_MMA(0, 1, At, B1); PG8_BAR; PG8_SCHED;
            PG8_LDA(At, 0, 1); PG8_STAGE(PG8_SB(0, 0), b2, voffB); PG8_STAGE(PG8_SB(0, 1), b2 + hstepB, voffB); PG8_STAGE(PG8_SA(0, 0), a2, voffA);
            PG8_WAIT_VX(12, 10); PG8_WAIT_L(0); PG8_BAR; PG8_MMA(1, 0, At, B0); PG8_MMA(1, 1, At, B1); PG8_BAR; PG8_SCHED;
            PG8_LDB(B0, 1, 0); PG8_LDB(B1, 1, 1); PG8_SCHED; PG8_LDA(At, 1, 0); PG8_STAGE(PG8_SA(0, 1), a2 + hstepA, voffA);
            PG8_WAIT_VX(10, 9); PG8_WAIT_L(0); PG8_BAR; PG8_MMA(0, 0, At, B0); PG8_MMA(0, 1, At, B1); PG8_BAR; PG8_SCHED;
            PG8_LDA(At, 1, 1); PG8_STAGE(PG8_SB(1, 0), b3, voffB); PG8_STAGE(PG8_SB(1, 1), b3 + hstepB, voffB); PG8_STAGE(PG8_SA(1, 0), a3, voffA);
            PG8_WAIT_V(8); PG8_WAIT_L(0); PG8_BAR; hk.rd(); PG8_MMA(1, 0, At, B0); hk.wr(); PG8_MMA(1, 1, At, B1); PG8_BAR; PG8_SCHED;
            } else {
            PG8_LDB(B0, 0, 0); PG8_SCHED; PG8_LDA(At, 0, 0); PG8_STAGE(PG8_SA(1, 1), a1 + hstepA, voffA);
            PG8_WAIT_L(8); PG8_BAR; PG8_WAIT_L(0); PG8_MMA(0, 0, At, B0); PG8_BAR; PG8_SCHED;
            PG8_LDB(B1, 0, 1); PG8_STAGE(PG8_SB(0, 0), b2, voffB);
            PG8_BAR; PG8_WAIT_L(0); PG8_MMA(0, 1, At, B1); PG8_BAR;
            PG8_LDA(At, 0, 1); PG8_STAGE(PG8_SA(0, 0), a2, voffA);
            PG8_BAR; PG8_WAIT_L(0); PG8_MMA(1, 0, At, B0); PG8_BAR; PG8_SCHED;
            PG8_STAGE(PG8_SB(0, 1), b2 + hstepB, voffB);
            PG8_WAIT_V(6); PG8_BAR; PG8_MMA(1, 1, At, B1); PG8_BAR;
            PG8_LDB(B0, 1, 0); PG8_SCHED; PG8_LDA(At, 1, 0); PG8_STAGE(PG8_SA(0, 1), a2 + hstepA, voffA);
            PG8_WAIT_L(8); PG8_BAR; PG8_WAIT_L(0); PG8_MMA(0, 0, At, B0); PG8_BAR; PG8_SCHED;
            PG8_LDB(B1, 1, 1); PG8_STAGE(PG8_SB(1, 0), b3, voffB);
            PG8_BAR; PG8_WAIT_L(0); PG8_MMA(0, 1, At, B1); PG8_BAR;
            PG8_LDA(At, 1, 1); PG8_STAGE(PG8_SA(1, 0), a3, voffA);
            PG8_BAR; PG8_WAIT_L(0); PG8_MMA(1, 0, At, B0); PG8_BAR; PG8_SCHED;
            PG8_STAGE(PG8_SB(1, 1), b3 + hstepB, voffB);
            PG8_WAIT_V(6); PG8_BAR; PG8_MMA(1, 1, At, B1); PG8_BAR;
            }
        }
        if constexpr (QM == 1) asm volatile("s_nop 15\n\ts_nop 15" ::: "memory");
        if constexpr (ALIGN_EPI) { if (wr == 0) PG8_BAR; }
        if constexpr (!Epi::AFTER_DRAIN) { E(acc, cur, wr, wc, fr, fq); S.done(cur); }
        if (!has_next) break;
#pragma unroll
        for (int a = 0; a < 2; ++a)
#pragma unroll
            for (int b = 0; b < 2; ++b)
#pragma unroll
                for (int m = 0; m < 4; ++m)
#pragma unroll
                    for (int n = 0; n < 2; ++n) acc[a][b][m][n] = (f32x4){0.f, 0.f, 0.f, 0.f};
        cur = nxt; cA = nA; cB = nB; ++ui;
        if constexpr (ALIGN_EPI) { if (wr == 1) PG8_BAR; }
    }
    hk.flush();
    PG8_WAIT_V(0);
    if constexpr (!ALIGN_EPI) { if (wr == 0) PG8_BAR; }
    PG8_BAR;
    if constexpr (Epi::AFTER_DRAIN) { E.fused(acc, cur, wr, wc, fr, fq, lds, wid, lane); S.done(cur); }
#undef PG8_SA
#undef PG8_SB
#undef PG8_STAGE
#undef PG8_LDA
#undef PG8_LDB
#undef PG8_MMA
#undef PG8_CAT8
#undef PG8_WAIT_V
#undef PG8_WAIT_VX
#undef PG8_WAIT_L
#undef PG8_BAR
#undef PG8_SCHED
}
}
#define LAS __attribute__((address_space(3)))
typedef unsigned short bf16;
typedef float f32x4 __attribute__((ext_vector_type(4)));
typedef float f32x16 __attribute__((ext_vector_type(16)));
typedef short bf16x8 __attribute__((ext_vector_type(8)));
typedef short s16x4 __attribute__((ext_vector_type(4)));
typedef unsigned u32x4 __attribute__((ext_vector_type(4)));
typedef unsigned u32x2 __attribute__((ext_vector_type(2)));
typedef float f32x2 __attribute__((ext_vector_type(2)));

constexpr int NWAVES = 8, NTHREADS = NWAVES * 64;
constexpr int MP = pg8::MP, MS = pg8::MS, M = pg8::MTOT;
constexpr int DM = 1024, DFF = 2816, NFF2 = 2 * DFF, NIN = 2560, DA = 512, DB = 512, NH = 8;
constexpr int SEQ = 8192, NBATCH = 8, DECB = 128, DECS = 4, WBUF = 2048;
constexpr float LN_EPS = 1e-5f;
constexpr size_t OUT_Y = 0;
constexpr size_t OUT_CKP = (size_t)M * DM;
constexpr size_t OUT_CVP = OUT_CKP + (size_t)NBATCH * WBUF * 512;
constexpr size_t OUT_CKS = OUT_CVP + (size_t)NBATCH * WBUF * 512;
constexpr size_t OUT_CVS = OUT_CKS + (size_t)DECB * WBUF * 512;
constexpr size_t OUT_SGV = OUT_CVS + (size_t)DECB * WBUF * 512;
constexpr size_t OUT_TOTAL = OUT_SGV + (size_t)DECB * DECS * 512;
constexpr size_t MiB = 1u << 20;
constexpr size_t WS_CTL = 0, CTL_ZERO_BYTES = 1 * MiB;
constexpr size_t WS_VEC = 1 * MiB;
constexpr size_t WS_SGUW = 1 * MiB + 256 * 1024;
constexpr size_t WS_VECP = 1 * MiB + 512 * 1024;
constexpr size_t WS_W1IN = 2 * MiB, WS_W1OUT = 13 * MiB, WS_WIN = 19 * MiB, WS_WOUT = 24 * MiB, WS_W2IN = 26 * MiB, WS_W2OUT = 37 * MiB;
constexpr size_t WS_ST1 = 43 * MiB, WS_ST2 = 52 * MiB;
constexpr size_t WS_LSE = 61 * MiB;
constexpr size_t WS_XB = 68 * MiB;
constexpr size_t WS_ZB = 197 * MiB;
constexpr size_t WS_Z = 326 * MiB;
constexpr size_t WS_QKV = 584 * MiB;
constexpr size_t WS_H = 907 * MiB;
constexpr size_t WS_XF8 = 1262 * MiB;
constexpr size_t WS_W1F8 = 1327 * MiB;
constexpr size_t WS_H8 = 1333 * MiB;
constexpr size_t WS_W1O8 = 1511 * MiB, WS_W2O8 = 1514 * MiB;
constexpr size_t WS_XS = 1517 * MiB;
constexpr size_t WS_END = 1518 * MiB;
static_assert(WS_W1IN + (size_t)NFF2 * DM * 2 <= WS_W1OUT && WS_W1OUT + (size_t)DM * DFF * 2 <= WS_WIN && WS_WIN + (size_t)NIN * DM * 2 <= WS_WOUT && WS_WOUT + (size_t)DM * DM * 2 <= WS_W2IN, "ws map 1");
static_assert(WS_W2IN + (size_t)NFF2 * DM * 2 <= WS_W2OUT && WS_W2OUT + (size_t)DM * DFF * 2 <= WS_ST1 && WS_ST1 + (size_t)M * 128 <= WS_ST2 && WS_ST2 + (size_t)M * 128 <= WS_LSE && WS_LSE + (size_t)3 * M * 32 <= WS_XB, "ws map 2");
static_assert(WS_XB + (size_t)M * DM * 2 <= WS_ZB && WS_ZB + (size_t)M * DM * 2 <= WS_Z && WS_Z + (size_t)M * DM * 4 <= WS_QKV && WS_QKV + (size_t)5 * M * 512 * 2 <= WS_H && WS_H + (size_t)M * DFF * 2 <= WS_XF8 && WS_XF8 + (size_t)M * DM <= WS_W1F8 && WS_W1F8 + (size_t)NFF2 * DM <= WS_H8 && WS_H8 + (size_t)M * DFF <= WS_W1O8 && WS_W1O8 + (size_t)DM * DFF <= WS_W2O8 && WS_W2O8 + (size_t)DM * DFF <= WS_XS && WS_XS + ((size_t)3 * M + 2 * NFF2) * 4 <= WS_END, "ws map 3");
constexpr int CW_BAR = 4096;
constexpr int RING_BYTES = 131072, MISC_OFF = RING_BYTES, EX_OFF = RING_BYTES + 1024, CPY_OFF = RING_BYTES + 2048, LDS_BYTES = 163840;

#define LDS_WAIT() asm volatile("s_waitcnt lgkmcnt(0)" ::: "memory")
__device__ __forceinline__ unsigned f2bf(float f) { unsigned u = __builtin_bit_cast(unsigned, f); return (u + 0x7fffu + ((u >> 16) & 1u)) >> 16; }
typedef float f32x2_t __attribute__((ext_vector_type(2))); typedef __bf16 bf16x2_t __attribute__((ext_vector_type(2)));
__device__ __forceinline__ unsigned pk2(float lo, float hi) { const f32x2_t v = {lo, hi}; const bf16x2_t b = __builtin_convertvector(v, bf16x2_t); return __builtin_bit_cast(unsigned, b); }
__device__ __forceinline__ unsigned pk4_fp8(float a, float b, float c, float d) { int w = __builtin_amdgcn_cvt_pk_fp8_f32(a, b, 0, false); w = __builtin_amdgcn_cvt_pk_fp8_f32(c, d, w, true); return (unsigned)w; }
__device__ __forceinline__ unsigned pk4_i8(float a, float b, float c, float d) { return ((unsigned)(int)__builtin_rintf(a) & 255u) | (((unsigned)(int)__builtin_rintf(b) & 255u) << 8) | (((unsigned)(int)__builtin_rintf(c) & 255u) << 16) | ((unsigned)(int)__builtin_rintf(d) << 24); }
__device__ __forceinline__ float bflo(unsigned w) { return __uint_as_float(w << 16); }
__device__ __forceinline__ float bfhi(unsigned w) { return __uint_as_float(w & 0xffff0000u); }
__device__ __forceinline__ float wave_sum(float v) {
#pragma unroll
    for (int o = 1; o < 64; o <<= 1) v += __shfl_xor(v, o);
    return v;
}
__device__ __forceinline__ float wave_max(float v) {
#pragma unroll
    for (int o = 1; o < 64; o <<= 1) v = fmaxf(v, __shfl_xor(v, o));
    return v;
}
__device__ __forceinline__ void unpack8(const u32x4 w, float (&v)[8]) { v[0] = bflo(w.x); v[1] = bfhi(w.x); v[2] = bflo(w.y); v[3] = bfhi(w.y); v[4] = bflo(w.z); v[5] = bfhi(w.z); v[6] = bflo(w.w); v[7] = bfhi(w.w); }
#define XB_TMO      128
#define XB_XCNT(j)  (256  + 64 * (j))
#define XB_XSUB(j)  (1280 + 64 * (j))
#define XB_XGEN(j)  (2304 + 64 * (j))
#define XB_TOP      3328
#define XB_TOPGEN   3392
#define XCD_BAR_WORDS 3456
#define XB_SPIN_CAP (1u << 18)

__device__ __forceinline__ unsigned xb_ld(unsigned* p)              { return __hip_atomic_load(p, __ATOMIC_RELAXED, __HIP_MEMORY_SCOPE_AGENT); }
__device__ __forceinline__ unsigned xb_add(unsigned* p, unsigned v) { return __hip_atomic_fetch_add(p, v, __ATOMIC_RELAXED, __HIP_MEMORY_SCOPE_AGENT); }
__device__ __forceinline__ unsigned xb_xcc_id() { return (unsigned)__builtin_amdgcn_s_getreg((3 << 11) | 20) & 0xFu; }
#define XB_SPIN(cond, bar) do { unsigned _sp = 0; while (cond) { __builtin_amdgcn_s_sleep(1); \
    if ((++_sp & 255u) == 0u) { if (xb_ld(&(bar)[XB_TMO])) break; if (_sp > XB_SPIN_CAP) { atomicAdd(&(bar)[XB_TMO], 1u); break; } } } } while (0)

struct XcdBarrier {
    unsigned* bar; unsigned x;
    volatile LAS unsigned* st;
};

__device__ __forceinline__ XcdBarrier xcd_barrier_post(unsigned* bar, volatile LAS unsigned* st) {
    XcdBarrier b; b.bar = bar; b.x = xb_xcc_id(); b.st = st;
    if (threadIdx.x == 0) (void)xb_add(&bar[XB_XCNT(b.x)], 1u);
    return b;
}
__device__ __forceinline__ void xcd_barrier_complete(unsigned* bar, unsigned x, unsigned& nloc, unsigned& nx) {
    const unsigned G = gridDim.x * gridDim.y * gridDim.z;
    unsigned sum, cnt, mine, sp = 0u;
    for (;;) {
        sum = 0u; cnt = 0u; mine = 0u;
#pragma unroll
        for (unsigned j = 0; j < 16; ++j) { const unsigned c = xb_ld(&bar[XB_XCNT(j)]); sum += c; cnt += (c > 0u) ? 1u : 0u; mine = (j == x) ? c : mine; }
        if (sum == G) break;
        __builtin_amdgcn_s_sleep(1);
        if ((++sp & 255u) == 0u) { if (xb_ld(&bar[XB_TMO])) break; if (sp > XB_SPIN_CAP) { atomicAdd(&bar[XB_TMO], 1u); break; } }
    }
    nloc = mine > 0u ? mine : 1u; nx = cnt > 0u ? cnt : 1u;
}

__device__ __forceinline__ void xcd_barrier(const XcdBarrier& b) {
    asm volatile("s_waitcnt vmcnt(0)" ::: "memory");
    __syncthreads();
    if (threadIdx.x == 0) {
        unsigned* bar = b.bar;
        __builtin_amdgcn_s_waitcnt(0);
        unsigned nloc = b.st[0], nx = b.st[1];
        if (nloc == 0u) { xcd_barrier_complete(bar, b.x, nloc, nx); b.st[0] = nloc; b.st[1] = nx; }
        const unsigned old = xb_add(&bar[XB_XSUB(b.x)], 1u);
        const unsigned gen = old / nloc;
        if (old + 1u == (gen + 1u) * nloc) {
            __builtin_amdgcn_fence(__ATOMIC_RELEASE, "agent");
            asm volatile("s_waitcnt vmcnt(0)" ::: "memory");
            const unsigned og = xb_add(&bar[XB_TOP], 1u);
            const unsigned tg = og / nx;
            if (og + 1u == (tg + 1u) * nx) xb_add(&bar[XB_TOPGEN], 1u);
            else XB_SPIN(xb_ld(&bar[XB_TOPGEN]) == tg, bar);
            __builtin_amdgcn_fence(__ATOMIC_ACQUIRE, "agent");
            xb_add(&bar[XB_XGEN(b.x)], 1u);
            asm volatile("s_waitcnt vmcnt(0)" ::: "memory");
        } else {
            XB_SPIN(xb_ld(&bar[XB_XGEN(b.x)]) == gen, bar);
            __builtin_amdgcn_fence(__ATOMIC_ACQUIRE, "agent");
            asm volatile("s_waitcnt vmcnt(0)" ::: "memory");
        }
    }
    __syncthreads();
}
#ifndef P1_F8_HALF
#define P1_F8_HALF 0
#endif
__device__ __forceinline__ void wprep_dma(const float* W, int N, int k0, int n0, LAS float* buf, int lane) {
#pragma unroll
    for (int i = 0; i < 8; ++i)
        __builtin_amdgcn_global_load_lds((const unsigned*)(W + (size_t)(k0 + 8 * i + (lane >> 3)) * N + n0 + 4 * (((lane & 7) - i) & 7)), (LAS unsigned*)(buf + i * 256), 16, 0, 0);
}
__device__ __forceinline__ int wprep_off(int c, int n) { return (8 * c) * 32 + (((((n) >> 2) + c) & 7) << 2) + (n & 3); }
template <bool SCALE, bool SUMS, bool F8 = false>
__device__ __forceinline__ void wprep_item(const float* W, int K, int N, bf16* WT, int n0, int rho0, int kb0, int nkb, const float* gsc, const float* bvec, float* s_out, float* t_out, LAS float* scr, int lane) {
    float sacc[4] = {0.f, 0.f, 0.f, 0.f}, tacc[4] = {0.f, 0.f, 0.f, 0.f};
    const int c = lane & 7;
    for (int kp = kb0; kp < kb0 + nkb; kp += 2) {
        wprep_dma(W, N, kp * 64, n0, scr, lane); wprep_dma(W, N, (kp + 1) * 64, n0, scr + 2048, lane);
        asm volatile("s_waitcnt vmcnt(0)" ::: "memory");
#pragma unroll
        for (int h = 0; h < 2; ++h) {
        const int kb = kp + h, k0 = kb * 64; const LAS float* buf = scr + h * 2048;
        float gk[8], bk[8];
        if (SCALE) { const f32x4 a = *(const f32x4*)(gsc + k0 + 8 * c), b = *(const f32x4*)(gsc + k0 + 8 * c + 4); gk[0] = a[0]; gk[1] = a[1]; gk[2] = a[2]; gk[3] = a[3]; gk[4] = b[0]; gk[5] = b[1]; gk[6] = b[2]; gk[7] = b[3]; }
        if (SUMS) { const f32x4 a = *(const f32x4*)(bvec + k0 + 8 * c), b = *(const f32x4*)(bvec + k0 + 8 * c + 4); bk[0] = a[0]; bk[1] = a[1]; bk[2] = a[2]; bk[3] = a[3]; bk[4] = b[0]; bk[5] = b[1]; bk[6] = b[2]; bk[7] = b[3]; }
#pragma unroll
        for (int j = 0; j < 4; ++j) {
            const int n = (lane >> 3) + 8 * j; const LAS float* s = buf + wprep_off(c, n);
            float v[8];
#pragma unroll
            for (int e = 0; e < 8; ++e) v[e] = s[e * 32];
            if (SUMS) {
#pragma unroll
                for (int e = 0; e < 8; ++e) tacc[j] += bk[e] * v[e];
            }
            if (SCALE) {
#pragma unroll
                for (int e = 0; e < 8; ++e) v[e] *= gk[e];
            }
            u32x4 o; o.x = pk2(v[0], v[1]); o.y = pk2(v[2], v[3]); o.z = pk2(v[4], v[5]); o.w = pk2(v[6], v[7]);
            if (SUMS) sacc[j] += ((bflo(o.x) + bfhi(o.x)) + (bflo(o.y) + bfhi(o.y))) + ((bflo(o.z) + bfhi(o.z)) + (bflo(o.w) + bfhi(o.w)));
            if (F8) { const int rho = rho0 + n, kk = k0 + 8 * c; u32x2 q; q.x = pk4_fp8(v[0] * 64.f, v[1] * 64.f, v[2] * 64.f, v[3] * 64.f); q.y = pk4_fp8(v[4] * 64.f, v[5] * 64.f, v[6] * 64.f, v[7] * 64.f);
                *(u32x2*)((unsigned char*)WT + (size_t)(rho >> 8) * ((size_t)256 * K) + (size_t)(kk >> 7) * (256 * 128) + (size_t)(rho & 255) * 128 + (kk & 127)) = q; }
            else { const int rho = rho0 + n; *(u32x4*)(WT + (size_t)(rho >> 8) * ((size_t)256 * K) + (size_t)kb * (256 * 64) + (size_t)(rho & 255) * 64 + 8 * c) = o; }
        }
        }
        LDS_WAIT(); asm volatile("" ::: "memory");
    }
    if (SUMS) {
#pragma unroll
        for (int j = 0; j < 4; ++j) {
            float s = sacc[j], t = tacc[j];
            s += __shfl_xor(s, 1); s += __shfl_xor(s, 2); s += __shfl_xor(s, 4);
            t += __shfl_xor(t, 1); t += __shfl_xor(t, 2); t += __shfl_xor(t, 4);
            if (c == 0) { const int n = (lane >> 3) + 8 * j; s_out[rho0 + n] = s; t_out[rho0 + n] = t; }
        }
    }
}
constexpr int I8_RED = CPY_OFF;
template <bool FOLDLN>
__device__ __forceinline__ void wprep_i8_wg(const float* W, int N, unsigned char* WT, int n0, int rho0, float* wsc, const float* gsc, const float* bvec, float* vecp, int vstride, LAS unsigned char* lds, int tid) {
    const int lane = tid & 63, wave = tid >> 6, c = lane & 7, nl = lane >> 3;
    LAS float* scr = (LAS float*)(lds + wave * 16384);
    LAS float* red = (LAS float*)(lds + I8_RED);
    static_assert(8 * 16384 <= MISC_OFF && I8_RED + 3 * 1024 <= LDS_BYTES, "int8 weight staging must not touch the barrier words");
    wprep_dma(W, N, (2 * wave) * 64, n0, scr, lane); wprep_dma(W, N, (2 * wave + 1) * 64, n0, scr + 2048, lane);
    asm volatile("s_waitcnt vmcnt(0)" ::: "memory");
    float gk[2][8], bk[2][8];
    if (FOLDLN) {
#pragma unroll
        for (int h = 0; h < 2; ++h) { const int kq = (2 * wave + h) * 64 + 8 * c;
            const f32x4 a = *(const f32x4*)(gsc + kq), b = *(const f32x4*)(gsc + kq + 4), a2 = *(const f32x4*)(bvec + kq), b2 = *(const f32x4*)(bvec + kq + 4);
            gk[h][0] = a[0]; gk[h][1] = a[1]; gk[h][2] = a[2]; gk[h][3] = a[3]; gk[h][4] = b[0]; gk[h][5] = b[1]; gk[h][6] = b[2]; gk[h][7] = b[3];
            bk[h][0] = a2[0]; bk[h][1] = a2[1]; bk[h][2] = a2[2]; bk[h][3] = a2[3]; bk[h][4] = b2[0]; bk[h][5] = b2[1]; bk[h][6] = b2[2]; bk[h][7] = b2[3]; }
    }
    float cmax[4] = {0.f, 0.f, 0.f, 0.f}, inv[4], qsum[4] = {0.f, 0.f, 0.f, 0.f}, tacc[4] = {0.f, 0.f, 0.f, 0.f};
#pragma unroll
    for (int h = 0; h < 2; ++h)
#pragma unroll
        for (int j = 0; j < 4; ++j) { const LAS float* s = scr + h * 2048 + wprep_off(c, nl + 8 * j);
#pragma unroll
            for (int e = 0; e < 8; ++e) { float v = s[e * 32]; if (FOLDLN) v *= gk[h][e]; cmax[j] = fmaxf(cmax[j], fabsf(v)); } }
#pragma unroll
    for (int j = 0; j < 4; ++j) { float m = cmax[j]; m = fmaxf(m, __shfl_xor(m, 1)); m = fmaxf(m, __shfl_xor(m, 2)); m = fmaxf(m, __shfl_xor(m, 4)); if (c == 0) red[wave * 32 + nl + 8 * j] = m; }
    __syncthreads();
#pragma unroll
    for (int j = 0; j < 4; ++j) { float m = 0.f;
#pragma unroll
        for (int w = 0; w < 8; ++w) m = fmaxf(m, red[w * 32 + nl + 8 * j]);
        inv[j] = m > 0.f ? 127.0f / m : 0.f; cmax[j] = m * (1.0f / 127.0f);
        if (wave == 0 && c == 0) wsc[rho0 + nl + 8 * j] = cmax[j]; }
#pragma unroll
    for (int h = 0; h < 2; ++h)
#pragma unroll
        for (int j = 0; j < 4; ++j) { const LAS float* s = scr + h * 2048 + wprep_off(c, nl + 8 * j);
            float v[8];
#pragma unroll
            for (int e = 0; e < 8; ++e) { v[e] = s[e * 32]; if (FOLDLN) { tacc[j] += bk[h][e] * v[e]; v[e] *= gk[h][e]; } v[e] = __builtin_rintf(v[e] * inv[j]); qsum[j] += v[e]; }
            u32x2 q; q.x = pk4_i8(v[0], v[1], v[2], v[3]); q.y = pk4_i8(v[4], v[5], v[6], v[7]);
            const int rho = rho0 + nl + 8 * j, kk = (2 * wave + h) * 64 + 8 * c;
            *(u32x2*)(WT + (size_t)(rho >> 8) * ((size_t)256 * 1024) + (size_t)(kk >> 7) * (256 * 128) + (size_t)(rho & 255) * 128 + (kk & 127)) = q; }
    if (FOLDLN) {
#pragma unroll
        for (int j = 0; j < 4; ++j) { float s = qsum[j], t = tacc[j];
            s += __shfl_xor(s, 1); s += __shfl_xor(s, 2); s += __shfl_xor(s, 4);
            t += __shfl_xor(t, 1); t += __shfl_xor(t, 2); t += __shfl_xor(t, 4);
            if (c == 0) { red[256 + wave * 32 + nl + 8 * j] = s; red[512 + wave * 32 + nl + 8 * j] = t; } }
        __syncthreads();
        if (tid < 32) { float s = 0.f, t = 0.f;
#pragma unroll
            for (int w = 0; w < 8; ++w) { s += red[256 + w * 32 + tid]; t += red[512 + w * 32 + tid]; }
            float m = 0.f;
#pragma unroll
            for (int w = 0; w < 8; ++w) m = fmaxf(m, red[w * 32 + tid]);
            const int rho = rho0 + tid; vecp[rho] = s * (m * (1.0f / 127.0f)); vecp[NFF2 + rho] = t;
#pragma unroll
            for (int q = 1; q < 4; ++q) { vecp[q * vstride + rho] = 0.f; vecp[q * vstride + NFF2 + rho] = 0.f; } }
    }
    __syncthreads();
}
__device__ __forceinline__ int ffn_rho(int n) { return (n < DFF) ? ((n >> 7) * 256 + (n & 127)) : (((n - DFF) >> 7) * 256 + 128 + ((n - DFF) & 127)); }

constexpr int VEC_FLOATS = 2 * NIN + 2 * NFF2;
__device__ __forceinline__ void vec_reduce(const float* VECP, float* VEC, int gt, int NGT) { for (int i = gt; i < VEC_FLOATS; i += NGT) VEC[i] = (VECP[i] + VECP[VEC_FLOATS + i]) + (VECP[2 * VEC_FLOATS + i] + VECP[3 * VEC_FLOATS + i]); }
struct P0Args {
    const float *xp, *xs, *ck, *cv, *w1in, *w1out, *ln1g, *ln1b, *win, *sguw, *oag, *obg, *wout, *ln2g, *ln2b, *w2in, *w2out;
    bf16 *W1F8, *W1O8, *W2O8, *W2I8, *W1IN, *W1OUT, *WIN, *WOUT, *W2IN, *W2OUT, *SGUW, *XB; unsigned char* XF8; float* XS; float* VECP; float* out;
};
__device__ __forceinline__ void p0_prologue(const P0Args& a, LAS unsigned char* lds, int vcu, int G, int tid) {
    const int lane = tid & 63, wave = tid >> 6;
    LAS float* scr = (LAS float*)(lds + wave * 16384);
    const int gw = vcu * NWAVES + wave, NGW = G * NWAVES;
    for (int it = vcu; it < 352; it += G) {
        if (it < 176) { const int n0 = it * 32; wprep_i8_wg<false>(a.w1in, NFF2, (unsigned char*)a.W1F8, n0, ffn_rho(n0), a.XS + M, nullptr, nullptr, nullptr, 0, lds, tid); }
        else { const int n0 = (it - 176) * 32; wprep_i8_wg<true>(a.w2in, NFF2, (unsigned char*)a.W2I8, n0, ffn_rho(n0), a.XS + M + NFF2, a.ln2g, a.ln2b, a.VECP + 2 * NIN, VEC_FLOATS, lds, tid); }
    }
    constexpr int J0 = 80 * 4, J1 = J0 + 32 * 11, J2 = J1 + 32 * 4, J3 = J2 + 32 * 11, J4 = J3 + 32 * 11, J5 = J4 + 32 * 11;
    for (int it = gw; it < J5; it += NGW) {
        if (it < J0) { const int r = it, n0 = (r >> 2) * 32, q = r & 3; float* pv = a.VECP + q * VEC_FLOATS; wprep_item<true, true>(a.win, DM, NIN, a.WIN, n0, n0, q * 4, 4, a.ln1g, a.ln1b, pv, pv + NIN, scr, lane); }
        else if (it < J1) { const int r = it - J0, n0 = (r / 11) * 32; wprep_item<false, false>(a.w1out, DFF, DM, a.W1OUT, n0, n0, (r % 11) * 4, 4, nullptr, nullptr, nullptr, nullptr, scr, lane); }
        else if (it < J2) { const int r = it - J1, n0 = (r >> 2) * 32, kb0 = (r & 3) * 4;
            wprep_item<true, false>(a.wout, DM, DM, a.WOUT, n0, n0, kb0, 4, (kb0 < 8) ? a.oag : (a.obg - 512), nullptr, nullptr, nullptr, scr, lane); }
        else if (it < J3) { const int r = it - J2, n0 = (r / 11) * 32; wprep_item<false, false>(a.w2out, DFF, DM, a.W2OUT, n0, n0, (r % 11) * 4, 4, nullptr, nullptr, nullptr, nullptr, scr, lane); }
        else if (it < J4) { const int r = it - J3, n0 = (r / 11) * 32; wprep_item<false, false, true>(a.w1out, DFF, DM, a.W1O8, n0, n0, (r % 11) * 4, 4, nullptr, nullptr, nullptr, nullptr, scr, lane); }
        else { const int r = it - J4, n0 = (r / 11) * 32; wprep_item<false, false, true>(a.w2out, DFF, DM, a.W2O8, n0, n0, (r % 11) * 4, 4, nullptr, nullptr, nullptr, nullptr, scr, lane); }
    }
    const int gt = vcu * NTHREADS + tid, NGT = G * NTHREADS;
    for (int i = gt; i < 4 * 128 * 128; i += NGT) { const int r = (i >> 7) & 127, cidx = i & 127; a.SGUW[i] = (bf16)f2bf((cidx <= r) ? a.sguw[i] : 0.f); }
    for (size_t row = gw; row < (size_t)M; row += 4 * (size_t)NGW) {
        f32x4 v[4][4];
#pragma unroll
        for (int q = 0; q < 4; ++q) { const size_t rq = row + (size_t)q * NGW; if (rq < (size_t)M) { const float* src = (rq < (size_t)MP) ? a.xp + rq * DM : a.xs + (rq - MP) * DM;
#pragma unroll
            for (int j = 0; j < 4; ++j) v[q][j] = __builtin_nontemporal_load((const f32x4*)(src + 4 * lane + 256 * j)); } }
#pragma unroll
        for (int q = 0; q < 4; ++q) { const size_t rq = row + (size_t)q * NGW; if (rq < (size_t)M) {
            float am = 0.f;
#pragma unroll
            for (int j = 0; j < 4; ++j) am = fmaxf(fmaxf(am, fmaxf(fabsf(v[q][j][0]), fabsf(v[q][j][1]))), fmaxf(fabsf(v[q][j][2]), fabsf(v[q][j][3])));
            am = wave_max(am);
            const float inv = am > 0.f ? 127.0f / am : 0.f;
            if (lane == 0) a.XS[rq] = am * (1.0f / 127.0f);
            unsigned char* xi = a.XF8 + (rq >> 8) * ((size_t)256 * DM) + (rq & 255) * 128;
#pragma unroll
            for (int j = 0; j < 4; ++j) {
                u32x2 o; o.x = pk2(v[q][j][0], v[q][j][1]); o.y = pk2(v[q][j][2], v[q][j][3]);
                if (rq >= (size_t)MP) *(u32x2*)(a.XB + rq * DM + 4 * lane + 256 * j) = o;
                const int c = 4 * lane + 256 * j;
                *(unsigned*)(xi + (size_t)(c >> 7) * (256 * 128) + (c & 127)) = pk4_i8(v[q][j][0] * inv, v[q][j][1] * inv, v[q][j][2] * inv, v[q][j][3] * inv);
            } } }
    }
}
__device__ __forceinline__ s16x4 tr_read(LAS unsigned char* p) {
    typedef short v4i16_t __attribute__((ext_vector_type(4)));
    return __builtin_bit_cast(s16x4, __builtin_amdgcn_ds_read_tr16_b64_v4i16((LAS v4i16_t*)p));
}
constexpr int ATT_K_OFF = 0, ATT_V_OFF = 49152, ATT_O_OFF = 98304;
struct AttnKV { u32x4 kv[6], vv[6]; bf16x8 qf[4]; };
__device__ __forceinline__ void attn_issue(AttnKV& R, const bf16* QB, const bf16* KB, const bf16* VB, int b, int dil, int r, int blk, int h, int tid) {
    const int s0 = blk * 256 - 128; const size_t rowb = (size_t)b * SEQ;
#pragma unroll
    for (int i = 0; i < 6; ++i) {
        const int c = tid + NTHREADS * i, row = c >> 3, ch = c & 7, s = s0 + row;
        R.kv[i] = (u32x4){0u, 0u, 0u, 0u}; R.vv[i] = (u32x4){0u, 0u, 0u, 0u};
        if (s >= 0) { const size_t off = (rowb + (size_t)r + (size_t)dil * s) * 512 + h * 64 + ch * 8; R.kv[i] = *(const u32x4*)(KB + off); R.vv[i] = *(const u32x4*)(VB + off); }
    }    const int lane = tid & 63, wid = tid >> 6, q = lane & 31, hh = lane >> 5;
    const size_t qrow = rowb + (size_t)r + (size_t)dil * (blk * 256 + 32 * wid + q);
#pragma unroll
    for (int d0 = 0; d0 < 4; ++d0) R.qf[d0] = *(const bf16x8*)(QB + qrow * 512 + h * 64 + 16 * d0 + 8 * hh);
}
__device__ __forceinline__ void attn_fill(LAS unsigned char* lds, const AttnKV& R, int tid) {
#pragma unroll
    for (int i = 0; i < 6; ++i) {
        const int c = tid + NTHREADS * i, row = c >> 3, ch = c & 7;
        *(LAS u32x4*)(lds + ATT_K_OFF + row * 128 + ((ch ^ ((row >> 1) & 7)) << 4)) = R.kv[i];
        *(LAS u32x4*)(lds + ATT_V_OFF + row * 128 + ((ch ^ (((row >> 1) & 1) << 2)) << 4)) = R.vv[i];
    }
}
__device__ __forceinline__ float lane32_max(float v) { const auto rr = __builtin_amdgcn_permlane32_swap(__float_as_uint(v), __float_as_uint(v), false, false); return fmaxf(__uint_as_float(rr[0]), __uint_as_float(rr[1])); }
__device__ __forceinline__ float lane32_sum(float v) { const auto rr = __builtin_amdgcn_permlane32_swap(__float_as_uint(v), __float_as_uint(v), false, false); return __uint_as_float(rr[0]) + __uint_as_float(rr[1]); }
__device__ __forceinline__ f32x16 att_qk(LAS unsigned char* lds, int rho0, const bf16x8 (&qf)[4], int q, int hh) {
    f32x16 sa;
#pragma unroll
    for (int i = 0; i < 16; ++i) sa[i] = 0.f;
#pragma unroll
    for (int d0 = 0; d0 < 4; ++d0) { const bf16x8 kf = *(const LAS bf16x8*)(lds + ATT_K_OFF + (rho0 + q) * 128 + (((2 * d0 + hh) ^ ((q >> 1) & 7)) << 4)); sa = __builtin_amdgcn_mfma_f32_32x32x16_bf16(kf, qf[d0], sa, 0, 0, 0); }
    return sa;
}
template <int TT> __device__ __forceinline__ void att_mask(f32x16& s, bool exists, int q, int hh) {
#pragma unroll
    for (int i = 0; i < 16; ++i) { const int kk = (i & 3) + 8 * (i >> 2) + 4 * hh; const bool off = !exists || (TT == 0 && kk < q) || (TT == 4 && kk > q); if (off) s[i] = -1e30f; }
}
__device__ __forceinline__ void att_pv(LAS unsigned char* lds, int rho0, const f32x16& p, f32x16& o0, f32x16& o1, int lane, int hh) {
    bf16x8 pf[2];
#pragma unroll
    for (int s = 0; s < 2; ++s) { u32x4 w; w.x = pk2(p[8 * s + 0], p[8 * s + 1]); w.y = pk2(p[8 * s + 2], p[8 * s + 3]); w.z = pk2(p[8 * s + 4], p[8 * s + 5]); w.w = pk2(p[8 * s + 6], p[8 * s + 7]); pf[s] = __builtin_bit_cast(bf16x8, w); }
#pragma unroll
    for (int s = 0; s < 2; ++s)
#pragma unroll
        for (int d0 = 0; d0 < 2; ++d0) {
            const int qq = (lane & 15) >> 2, rowA = rho0 + 16 * s + 4 * hh + qq;
            const int chv = (4 * d0 + 2 * ((lane >> 4) & 1) + ((lane & 3) >> 1)) ^ ((qq >> 1) << 2);
            LAS unsigned char* addrA = lds + ATT_V_OFF + rowA * 128 + (chv << 4) + 8 * (lane & 1);
            const s16x4 va = tr_read(addrA), vb = tr_read(addrA + 8 * 128);
            const bf16x8 vf = (bf16x8){va[0], va[1], va[2], va[3], vb[0], vb[1], vb[2], vb[3]};
            if (d0 == 0) o0 = __builtin_amdgcn_mfma_f32_32x32x16_bf16(vf, pf[s], o0, 0, 0, 0); else o1 = __builtin_amdgcn_mfma_f32_32x32x16_bf16(vf, pf[s], o1, 0, 0, 0);
        }
}
template <int TA, int TB> __device__ __forceinline__ void att_round(LAS unsigned char* lds, const bf16x8 (&qf)[4], f32x16& o0, f32x16& o1, float& m, float& l, int s0, int wid, int lane, int q, int hh) {
    const int rho0a = 32 * wid + 32 * TA, rho0b = 32 * wid + 32 * (TB < 0 ? TA : TB);
    const bool ea = s0 + rho0a >= 0, eb = (TB >= 0) && (s0 + rho0b >= 0);
    if (!(ea || eb)) return;
    f32x16 sa = att_qk(lds, rho0a, qf, q, hh), sb;
    if (TB >= 0) sb = att_qk(lds, rho0b, qf, q, hh);
    att_mask<TA>(sa, ea, q, hh);
    if (TB >= 0) att_mask<TB>(sb, eb, q, hh);
    float mx = sa[0];
#pragma unroll
    for (int i = 1; i < 16; ++i) mx = fmaxf(mx, sa[i]);
    if (TB >= 0) {
#pragma unroll
        for (int i = 0; i < 16; ++i) mx = fmaxf(mx, sb[i]);
    }
    mx = lane32_max(mx);
    const float mn = fmaxf(m, mx), alpha = __builtin_amdgcn_exp2f(m - mn);
    m = mn;
    float ps = 0.f;
#pragma unroll
    for (int i = 0; i < 16; ++i) { sa[i] = __builtin_amdgcn_exp2f(sa[i] - mn); ps += sa[i]; }
    if (TB >= 0) {
#pragma unroll
        for (int i = 0; i < 16; ++i) { sb[i] = __builtin_amdgcn_exp2f(sb[i] - mn); ps += sb[i]; }
    }
    l = l * alpha + lane32_sum(ps);
#pragma unroll
    for (int i = 0; i < 16; ++i) { o0[i] *= alpha; o1[i] *= alpha; }
    att_pv(lds, rho0a, sa, o0, o1, lane, hh);
    if (TB >= 0) att_pv(lds, rho0b, sb, o0, o1, lane, hh);
}
__device__ __forceinline__ void attn_compute(LAS unsigned char* lds, const bf16x8 (&qf)[4], bf16* OPg, float* LSEg, int b, int dil, int r, int blk, int h, int tid) {
    const int lane = tid & 63, wid = tid >> 6;
    const int s0 = blk * 256 - 128;
    const size_t rowb = (size_t)b * SEQ;
    const int q = lane & 31, hh = lane >> 5;
    const int sq = blk * 256 + 32 * wid + q;
    const size_t qrow = rowb + (size_t)r + (size_t)dil * sq;
    f32x16 o0, o1;
#pragma unroll
    for (int i = 0; i < 16; ++i) { o0[i] = 0.f; o1[i] = 0.f; }
    float m = -1e30f, l = 0.f;
    att_round<0, 1>(lds, qf, o0, o1, m, l, s0, wid, lane, q, hh);
    att_round<2, 3>(lds, qf, o0, o1, m, l, s0, wid, lane, q, hh);
    att_round<4, -1>(lds, qf, o0, o1, m, l, s0, wid, lane, q, hh);
    const float inv = 1.0f / l;
    LAS unsigned char* stg = lds + ATT_O_OFF + wid * 4096;
#pragma unroll
    for (int g4 = 0; g4 < 4; ++g4) {
        u32x2 w0, w1;
        w0.x = pk2(o0[4 * g4 + 0] * inv, o0[4 * g4 + 1] * inv); w0.y = pk2(o0[4 * g4 + 2] * inv, o0[4 * g4 + 3] * inv);
        w1.x = pk2(o1[4 * g4 + 0] * inv, o1[4 * g4 + 1] * inv); w1.y = pk2(o1[4 * g4 + 2] * inv, o1[4 * g4 + 3] * inv);
        *(LAS u32x2*)(stg + q * 128 + ((g4 ^ ((q >> 1) & 7)) << 4) + 8 * hh) = w0;
        *(LAS u32x2*)(stg + q * 128 + (((4 + g4) ^ ((q >> 1) & 7)) << 4) + 8 * hh) = w1;
    }
    LDS_WAIT();
    {
        const size_t rbase = rowb + (size_t)r + (size_t)dil * (blk * 256 + 32 * wid);
#pragma unroll
        for (int i4 = 0; i4 < 4; ++i4) {
            const int rl = 8 * i4 + (lane >> 3), ch = lane & 7;
            const u32x4 v = *(const LAS u32x4*)(stg + rl * 128 + ((ch ^ ((rl >> 1) & 7)) << 4));
            __builtin_nontemporal_store(v, (u32x4*)(OPg + (rbase + (size_t)dil * rl) * 512 + h * 64 + ch * 8));
        }
    }
    if (hh == 0) LSEg[qrow * 8 + h] = m + log2f(l);
    __syncthreads();
}

__device__ __forceinline__ void dec_update(float sc, const float (&v)[8], float& m, float& l, float (&o)[8]) {
    const float mn = fmaxf(m, sc), alpha = __builtin_amdgcn_exp2f(m - mn), p = __builtin_amdgcn_exp2f(sc - mn);
    m = mn; l = l * alpha + p;
#pragma unroll
    for (int e = 0; e < 8; ++e) o[e] = o[e] * alpha + p * v[e];
}
__device__ __forceinline__ void decode_task(const bf16* QB, const bf16* KB, const bf16* VB, const float* ck, const float* cv, bf16* OP0, int b, int h, int t, int lane) {
    const int kq = lane >> 3, dp = lane & 7;
    const size_t row = (size_t)MP + 4 * b + t;
    float qv[8]; unpack8(*(const u32x4*)(QB + row * 512 + h * 64 + 8 * dp), qv);
    const float* ckb = ck + (size_t)b * WBUF * 512 + h * 64 + 8 * dp; const float* cvb = cv + (size_t)b * WBUF * 512 + h * 64 + 8 * dp;
    float m = -1e30f, l = 0.f, o[8];
#pragma unroll
    for (int e = 0; e < 8; ++e) o[e] = 0.f;
    for (int r0 = 0; r0 < 49; r0 += 7) {
        f32x4 k0[7], k1[7], v0[7], v1[7]; bool ok[7];
#pragma unroll
        for (int u = 0; u < 7; ++u) {
            const int s = (r0 + u) * 8 + kq, g = s / 129, j = s - 129 * g, idx = WBUF + t - (j << (2 * g));
            ok[u] = s < 387 && idx < WBUF;
            const size_t ro = (size_t)(ok[u] ? idx : 0) * 512;
            k0[u] = *(const f32x4*)(ckb + ro); k1[u] = *(const f32x4*)(ckb + ro + 4); v0[u] = *(const f32x4*)(cvb + ro); v1[u] = *(const f32x4*)(cvb + ro + 4);
        }
#pragma unroll
        for (int u = 0; u < 7; ++u) {
            float sc = ((qv[0] * k0[u][0] + qv[1] * k0[u][1]) + (qv[2] * k0[u][2] + qv[3] * k0[u][3])) + ((qv[4] * k1[u][0] + qv[5] * k1[u][1]) + (qv[6] * k1[u][2] + qv[7] * k1[u][3]));
            sc += __shfl_xor(sc, 1); sc += __shfl_xor(sc, 2); sc += __shfl_xor(sc, 4);
            sc = ok[u] ? sc : -1e30f;
            const float vv[8] = {v0[u][0], v0[u][1], v0[u][2], v0[u][3], v1[u][0], v1[u][1], v1[u][2], v1[u][3]};
            dec_update(sc, vv, m, l, o);
        }
    }
    {
        const bool nok = (kq < 4) ? (kq <= t) : (kq < 6); const int nr = (kq < 4 && kq <= t) ? (t - kq) : t;
        float kv8[8], vv[8];
        unpack8(*(const u32x4*)(KB + ((size_t)MP + 4 * b + nr) * 512 + h * 64 + 8 * dp), kv8); unpack8(*(const u32x4*)(VB + ((size_t)MP + 4 * b + nr) * 512 + h * 64 + 8 * dp), vv);
        float sc = 0.f;
#pragma unroll
        for (int e = 0; e < 8; ++e) sc += qv[e] * kv8[e];
        sc += __shfl_xor(sc, 1); sc += __shfl_xor(sc, 2); sc += __shfl_xor(sc, 4);
        sc = nok ? sc : -1e30f;
        dec_update(sc, vv, m, l, o);
    }
    float M = m;
    M = fmaxf(M, __shfl_xor(M, 8)); M = fmaxf(M, __shfl_xor(M, 16)); M = fmaxf(M, __shfl_xor(M, 32));
    const float f = __builtin_amdgcn_exp2f(m - M);
    l *= f;
    l += __shfl_xor(l, 8); l += __shfl_xor(l, 16); l += __shfl_xor(l, 32);
#pragma unroll
    for (int e = 0; e < 8; ++e) { float x = o[e] * f; x += __shfl_xor(x, 8); x += __shfl_xor(x, 16); x += __shfl_xor(x, 32); o[e] = x; }
    if (kq == 0) {
        const float inv = 1.0f / l;
        u32x4 w; w.x = pk2(o[0] * inv, o[1] * inv); w.y = pk2(o[2] * inv, o[3] * inv); w.z = pk2(o[4] * inv, o[5] * inv); w.w = pk2(o[6] * inv, o[7] * inv);
        *(u32x4*)(OP0 + row * 512 + h * 64 + 8 * dp) = w;
    }
}

__device__ __forceinline__ void sgu_unit(LAS unsigned char* lds, const bf16* UB, const bf16* VBB, const bf16* SW, const float* sgb, const float* gvp, const float* bvp, bf16* OAB, int chunk, int tid) {
    const int lane = tid & 63, wid = tid >> 6;
    const size_t R0 = (size_t)chunk * 128;
    {
        float gv8[8], bv8[8];
        { const f32x4 a = *(const f32x4*)(gvp + lane * 8), b2 = *(const f32x4*)(gvp + lane * 8 + 4), c = *(const f32x4*)(bvp + lane * 8), d = *(const f32x4*)(bvp + lane * 8 + 4);
#pragma unroll
          for (int e = 0; e < 4; ++e) { gv8[e] = a[e]; gv8[4 + e] = b2[e]; bv8[e] = c[e]; bv8[4 + e] = d[e]; } }
#pragma unroll 4
        for (int jj = 0; jj < 16; ++jj) {
            const int j = wid * 16 + jj;
            const u32x4 w = *(const u32x4*)(VBB + (R0 + j) * 512 + lane * 8); float v[8]; unpack8(w, v);
            float s = 0.f;
#pragma unroll
            for (int e = 0; e < 8; ++e) s += v[e];
            const float mean = wave_sum(s) * (1.0f / 512.0f); float qq = 0.f;
#pragma unroll
            for (int e = 0; e < 8; ++e) { v[e] -= mean; qq += v[e] * v[e]; }
            const float rstd = 1.0f / sqrtf(wave_sum(qq) * (1.0f / 512.0f) + LN_EPS);
#pragma unroll
            for (int e = 0; e < 8; ++e) v[e] = v[e] * rstd * gv8[e] + bv8[e];
            u32x4 o; o.x = pk2(v[0], v[1]); o.y = pk2(v[2], v[3]); o.z = pk2(v[4], v[5]); o.w = pk2(v[6], v[7]);
            *(LAS u32x4*)(lds + j * 1024 + ((lane ^ ((j & 3) << 2)) << 4)) = o;
        }
    }
    __syncthreads();
    const int it = wid & 3, cp = wid >> 2, il = lane & 31, hh = lane >> 5;
    const int i = 32 * it + il; const size_t row = R0 + i;
    const int qq = (lane & 15) >> 2;
    float ss = 0.f;
    for (int gi = 0; gi < 4; ++gi) {
        f32x16 acc[2];
#pragma unroll
        for (int c2 = 0; c2 < 2; ++c2)
#pragma unroll
            for (int x = 0; x < 16; ++x) acc[c2][x] = 0.f;
        for (int ks = 0; ks <= 2 * it + 1; ++ks) {
            const bf16x8 wf = *(const bf16x8*)(SW + ((size_t)(gi * 128 + 32 * it + il)) * 128 + 16 * ks + 8 * hh);
#pragma unroll
            for (int c2 = 0; c2 < 2; ++c2) {
                const int ch = (gi * 16 + (2 * cp + c2) * 4 + 2 * ((lane >> 4) & 1) + ((lane & 3) >> 1)) ^ (qq << 2);
                LAS unsigned char* ap = lds + (16 * ks + 8 * hh + qq) * 1024 + (ch << 4) + 8 * (lane & 1);
                const s16x4 va = tr_read(ap), vb = tr_read(ap + 4 * 1024);
                const bf16x8 af = (bf16x8){va[0], va[1], va[2], va[3], vb[0], vb[1], vb[2], vb[3]};
                acc[c2] = __builtin_amdgcn_mfma_f32_32x32x16_bf16(af, wf, acc[c2], 0, 0, 0);
            }
        }
        __syncthreads();
        const float bias = sgb[gi * 128 + i];
#pragma unroll
        for (int c2 = 0; c2 < 2; ++c2)
#pragma unroll
            for (int g4 = 0; g4 < 4; ++g4) {
                const int cl = (2 * cp + c2) * 32 + 8 * g4 + 4 * hh;
                const u32x2 uw = *(const u32x2*)(UB + row * 512 + gi * 128 + cl);
                const float x0 = bflo(uw.x) * (acc[c2][4 * g4 + 0] + bias), x1 = bfhi(uw.x) * (acc[c2][4 * g4 + 1] + bias), x2 = bflo(uw.y) * (acc[c2][4 * g4 + 2] + bias), x3 = bfhi(uw.y) * (acc[c2][4 * g4 + 3] + bias);
                ss += (x0 * x0 + x1 * x1) + (x2 * x2 + x3 * x3);
                u32x2 w; w.x = pk2(x0, x1); w.y = pk2(x2, x3);
                const int ch = (gi * 16 + (2 * cp + c2) * 4 + g4) ^ ((i & 3) << 2);
                *(LAS u32x2*)(lds + i * 1024 + (ch << 4) + 8 * hh) = w;
            }
    }
    ss += __shfl_xor(ss, 32);
    LAS float* ex = (LAS float*)(lds + EX_OFF);
    if (hh == 0) ex[wid * 32 + il] = ss;
    __syncthreads();
    {
        const int i2 = tid >> 2, gq = tid & 3;
        const float tot = ex[(i2 >> 5) * 32 + (i2 & 31)] + ex[((i2 >> 5) + 4) * 32 + (i2 & 31)];
        const float rr = 1.0f / sqrtf(tot * (1.0f / 512.0f) + LN_EPS);
        bf16* orow = OAB + (R0 + i2) * 1024 + 512 + gq * 128;
#pragma unroll
        for (int c8 = 0; c8 < 16; ++c8) {
            const u32x4 w = *(const LAS u32x4*)(lds + i2 * 1024 + (((gq * 16 + c8) ^ ((i2 & 3) << 2)) << 4)); float v[8]; unpack8(w, v);
            u32x4 o; o.x = pk2(v[0] * rr, v[1] * rr); o.y = pk2(v[2] * rr, v[3] * rr); o.z = pk2(v[4] * rr, v[5] * rr); o.w = pk2(v[6] * rr, v[7] * rr);
            *(u32x4*)(orow + c8 * 8) = o;
        }
    }
    __syncthreads();
}

__device__ __forceinline__ void sgu_sample(const bf16* UB, const bf16* VBB, const float* sgw, const float* sgb, const float* gvp, const float* bvp, bf16* OAB, float* out_sgv, int b, int lane) {
    float gv8[8], bv8[8];
    { const f32x4 a = *(const f32x4*)(gvp + lane * 8), b2 = *(const f32x4*)(gvp + lane * 8 + 4), c = *(const f32x4*)(bvp + lane * 8), d = *(const f32x4*)(bvp + lane * 8 + 4);
#pragma unroll
      for (int e = 0; e < 4; ++e) { gv8[e] = a[e]; gv8[4 + e] = b2[e]; bv8[e] = c[e]; bv8[4 + e] = d[e]; } }
    float vn[4][8];
#pragma unroll
    for (int t = 0; t < 4; ++t) {
        const size_t row = (size_t)MP + 4 * b + t;
        const u32x4 w = *(const u32x4*)(VBB + row * 512 + lane * 8); float v[8]; unpack8(w, v);
        float s = 0.f;
#pragma unroll
        for (int e = 0; e < 8; ++e) s += v[e];
        const float mean = wave_sum(s) * (1.0f / 512.0f); float qq = 0.f;
#pragma unroll
        for (int e = 0; e < 8; ++e) { v[e] -= mean; qq += v[e] * v[e]; }
        const float rstd = 1.0f / sqrtf(wave_sum(qq) * (1.0f / 512.0f) + LN_EPS);
#pragma unroll
        for (int e = 0; e < 8; ++e) vn[t][e] = v[e] * rstd * gv8[e] + bv8[e];
        float* op = out_sgv + ((size_t)b * 4 + t) * 512 + lane * 8;
        *(f32x4*)op = (f32x4){vn[t][0], vn[t][1], vn[t][2], vn[t][3]}; *(f32x4*)(op + 4) = (f32x4){vn[t][4], vn[t][5], vn[t][6], vn[t][7]};
    }
    const int gi = lane >> 4;
#pragma unroll
    for (int i = 0; i < 4; ++i) {
        const size_t row = (size_t)MP + 4 * b + i;
        const float bias = sgb[gi * 128 + i];
        float mix[8];
#pragma unroll
        for (int e = 0; e < 8; ++e) mix[e] = bias;
#pragma unroll
        for (int j = 0; j <= i; ++j) { const float wij = sgw[(size_t)(gi * 128 + i) * 128 + j];
#pragma unroll
            for (int e = 0; e < 8; ++e) mix[e] += wij * vn[j][e]; }
        const u32x4 uw = *(const u32x4*)(UB + row * 512 + lane * 8); float u[8]; unpack8(uw, u);
        float ss = 0.f;
#pragma unroll
        for (int e = 0; e < 8; ++e) { mix[e] *= u[e]; ss += mix[e] * mix[e]; }
        const float rr = 1.0f / sqrtf(wave_sum(ss) * (1.0f / 512.0f) + LN_EPS);
        u32x4 o; o.x = pk2(mix[0] * rr, mix[1] * rr); o.y = pk2(mix[2] * rr, mix[3] * rr); o.z = pk2(mix[4] * rr, mix[5] * rr); o.w = pk2(mix[6] * rr, mix[7] * rr);
        *(u32x4*)(OAB + row * 1024 + 512 + lane * 8) = o;
    }
}

struct CombIn { u32x4 a, b, c; float l0, l1, l2; };
__device__ __forceinline__ void combine_load(CombIn& I, const bf16* OP, const float* LSE, size_t row, int lane) {
    I.a = *(const u32x4*)(OP + row * 512 + lane * 8);
    if (row < (size_t)MP) {
        const int head = lane >> 3;
        I.l0 = LSE[row * 8 + head]; I.l1 = LSE[((size_t)M + row) * 8 + head]; I.l2 = LSE[((size_t)2 * M + row) * 8 + head];
        I.b = *(const u32x4*)(OP + ((size_t)M + row) * 512 + lane * 8); I.c = *(const u32x4*)(OP + ((size_t)2 * M + row) * 512 + lane * 8);
    }
}
__device__ __forceinline__ void combine_finish(const CombIn& I, bf16* OAB, size_t row, int lane) {
    float o[8];
    if (row < (size_t)MP) {
        const float mx = fmaxf(I.l0, fmaxf(I.l1, I.l2));
        float w0 = __builtin_amdgcn_exp2f(I.l0 - mx), w1 = __builtin_amdgcn_exp2f(I.l1 - mx), w2 = __builtin_amdgcn_exp2f(I.l2 - mx);
        const float inv = 1.0f / (w0 + w1 + w2); w0 *= inv; w1 *= inv; w2 *= inv;
        float a[8], b2[8], c[8];
        unpack8(I.a, a); unpack8(I.b, b2); unpack8(I.c, c);
#pragma unroll
        for (int e = 0; e < 8; ++e) o[e] = w0 * a[e] + w1 * b2[e] + w2 * c[e];
    } else unpack8(I.a, o);
    float ss = 0.f;
#pragma unroll
    for (int e = 0; e < 8; ++e) ss += o[e] * o[e];
    const float rr = 1.0f / sqrtf(wave_sum(ss) * (1.0f / 512.0f) + LN_EPS);
    u32x4 w; w.x = pk2(o[0] * rr, o[1] * rr); w.y = pk2(o[2] * rr, o[3] * rr); w.z = pk2(o[4] * rr, o[5] * rr); w.w = pk2(o[6] * rr, o[7] * rr);
    *(u32x4*)(OAB + row * 1024 + lane * 8) = w;
}
struct LnIn { u32x2 w[4]; };
__device__ __forceinline__ void final_ln_load(LnIn& I, const bf16* zrow, int lane) {
#pragma unroll
    for (int j = 0; j < 4; ++j) I.w[j] = *(const u32x2*)(zrow + 4 * lane + 256 * j);
}
__device__ __forceinline__ void final_ln_finish(const LnIn& I, float* y, const float* g, const float* bvec, int lane) {
    f32x4 v[4]; float s = 0.f;
#pragma unroll
    for (int j = 0; j < 4; ++j) { v[j] = (f32x4){bflo(I.w[j].x), bfhi(I.w[j].x), bflo(I.w[j].y), bfhi(I.w[j].y)}; s += (v[j][0] + v[j][1]) + (v[j][2] + v[j][3]); }
    const float mean = wave_sum(s) * (1.0f / 1024.0f); float qq = 0.f;
#pragma unroll
    for (int j = 0; j < 4; ++j) { v[j] = v[j] - mean; qq += (v[j][0] * v[j][0] + v[j][1] * v[j][1]) + (v[j][2] * v[j][2] + v[j][3] * v[j][3]); }
    const float rstd = 1.0f / sqrtf(wave_sum(qq) * (1.0f / 1024.0f) + LN_EPS);
#pragma unroll
    for (int j = 0; j < 4; ++j) { const f32x4 gg = *(const f32x4*)(g + 4 * lane + 256 * j), bb = *(const f32x4*)(bvec + 4 * lane + 256 * j); __builtin_nontemporal_store(v[j] * rstd * gg + bb, (f32x4*)(y + 4 * lane + 256 * j)); }
}

template <int MODE, bool STATS, bool ATILE>
__device__ __forceinline__ void small_res_unit(LAS unsigned char* lds, const bf16* A, const bf16* Bt, int K, int rb, int cb, const bf16* rsrc, const float* stprev, const float* g, const float* bvec, bf16* zb, float* stout, float scale, int tid_in) {
    int tid = tid_in; asm volatile("" : "+v"(tid));
    const int lane = tid & 63, wid = tid >> 6, fr = lane & 15, fq = lane >> 4;
    const int row0 = MP + rb * 32, col0 = cb * 64;
    const int kw = K >> 3, nks = kw >> 5;
    const bf16* ap = ATILE ? A + (size_t)(row0 >> 8) * ((size_t)256 * K) + (size_t)((row0 & 255) + fr) * 64 + 8 * fq : A + (size_t)(row0 + fr) * K + wid * kw + 8 * fq;
    const bf16* bp = Bt + (size_t)(col0 >> 8) * ((size_t)256 * K) + (size_t)((col0 & 255) + fr) * 64 + 8 * fq;
    f32x4 acc[2][4];
#pragma unroll
    for (int mt = 0; mt < 2; ++mt)
#pragma unroll
        for (int nt = 0; nt < 4; ++nt) acc[mt][nt] = (f32x4){0.f, 0.f, 0.f, 0.f};
#pragma unroll 2
    for (int ks = 0; ks < nks; ++ks) {
        bf16x8 af[2], bfr[4];
#pragma unroll
        for (int mt = 0; mt < 2; ++mt) { const int kc = wid * kw + ks * 32; af[mt] = ATILE ? *(const bf16x8*)(ap + (size_t)(kc >> 6) * (256 * 64) + mt * 16 * 64 + (kc & 63)) : *(const bf16x8*)(ap + (size_t)mt * 16 * K + ks * 32); }
#pragma unroll
        for (int nt = 0; nt < 4; ++nt) { const int kc = wid * kw + ks * 32; bfr[nt] = *(const bf16x8*)(bp + (size_t)(kc >> 6) * (256 * 64) + nt * 16 * 64 + (kc & 63)); }
#pragma unroll
        for (int mt = 0; mt < 2; ++mt)
#pragma unroll
            for (int nt = 0; nt < 4; ++nt) acc[mt][nt] = __builtin_amdgcn_mfma_f32_16x16x32_bf16(bfr[nt], af[mt], acc[mt][nt], 0, 0, 0);
    }
#pragma unroll
    for (int mt = 0; mt < 2; ++mt)
#pragma unroll
        for (int nt = 0; nt < 4; ++nt) *(LAS f32x4*)(lds + wid * 8192 + ((16 * mt + fr) * 64 + 16 * nt + 4 * fq) * 4) = acc[mt][nt];
    __syncthreads();
    const int tok = tid >> 4, n4 = (tid & 15) * 4;
    f32x4 v = *(const LAS f32x4*)(lds + (tok * 64 + n4) * 4);
#pragma unroll
    for (int w = 1; w < 8; ++w) v = v + *(const LAS f32x4*)(lds + w * 8192 + (tok * 64 + n4) * 4);
    const size_t row = (size_t)row0 + tok; const int col = col0 + n4;
    const u32x2 rw = *(const u32x2*)(rsrc + row * 1024 + col);
    f32x4 r = (f32x4){bflo(rw.x), bfhi(rw.x), bflo(rw.y), bfhi(rw.y)};
    if (MODE == 1) { float mean, rstd; pg8::combine16(stprev + row * 32, mean, rstd); r = (r - mean) * rstd * *(const f32x4*)(g + col) + *(const f32x4*)(bvec + col); }
    const f32x4 z = r * pg8::DN_ALPHA + v * scale;
    if (STATS) {
        float s = (z[0] + z[1]) + (z[2] + z[3]);
        s += __shfl_xor(s, 1); s += __shfl_xor(s, 2); s += __shfl_xor(s, 4); s += __shfl_xor(s, 8);
        const float mw = s * (1.0f / 64.0f); const f32x4 d = z - mw;
        float q = (d[0] * d[0] + d[1] * d[1]) + (d[2] * d[2] + d[3] * d[3]);
        q += __shfl_xor(q, 1); q += __shfl_xor(q, 2); q += __shfl_xor(q, 4); q += __shfl_xor(q, 8);
        if ((tid & 15) == 0) *(f32x2*)(stout + row * 32 + cb * 2) = (f32x2){mw, q};
    }
    u32x2 w; w.x = pk2(z[0], z[1]); w.y = pk2(z[2], z[3]);
    *(u32x2*)(zb + row * 1024 + col) = w;
    __syncthreads();
}
struct Args { const float* in[22]; float* out; unsigned char* ws; };
typedef const __attribute__((address_space(4))) unsigned char* karg_ptr;
__device__ __forceinline__ const float* karg_in(int k) { karg_ptr kp = (karg_ptr)__builtin_amdgcn_kernarg_segment_ptr(); asm volatile("" : "+s"(kp)); return *(const float* const __attribute__((address_space(4)))*)(kp + 8 * k); }
__device__ __forceinline__ float* karg_out() { karg_ptr kp = (karg_ptr)__builtin_amdgcn_kernarg_segment_ptr(); asm volatile("" : "+s"(kp)); return *(float* const __attribute__((address_space(4)))*)(kp + 176); }
__device__ __forceinline__ unsigned char* karg_ws() { karg_ptr kp = (karg_ptr)__builtin_amdgcn_kernarg_segment_ptr(); asm volatile("" : "+s"(kp)); return *(unsigned char* const __attribute__((address_space(4)))*)(kp + 184); }
static_assert(sizeof(Args) == 192, "Args layout");
template <int R> struct CopyHook {
    static constexpr int EXTRA = 2 * R;
    const float* src; float* dst; float* sink; int row, row_end, pr0, pr1; unsigned off; LAS unsigned char* stg; int wid;
    __device__ __forceinline__ void init(const float* ck, const float* cv, float* out, float* sink_, LAS unsigned char* stg_, int seg, int r0, int r1, int tid) {
        const int which = seg >> 7, b = seg & 127;
        src = (which ? cv : ck) + (size_t)b * WBUF * 512 + 2048; dst = out + (which ? OUT_CVS : OUT_CKS) + (size_t)b * WBUF * 512; sink = sink_; stg = stg_; row = r0; row_end = r1; off = (unsigned)tid * 4u; pr0 = r0; pr1 = r0;
        wid = __builtin_amdgcn_readfirstlane(tid >> 6);
    }
    __device__ __forceinline__ void prime() {
        *(f32x4*)(sink + off) = (f32x4){0.f, 0.f, 0.f, 0.f}; if (R == 2) *(f32x4*)(sink + 2048 + off) = (f32x4){0.f, 0.f, 0.f, 0.f};
    }
    __device__ __forceinline__ void ld() {
        pr0 = row < row_end - 1 ? row : row_end - 1; pr1 = row + 1 < row_end - 1 ? row + 1 : row_end - 1; row += R;
        __builtin_amdgcn_global_load_lds((const unsigned*)(src + (size_t)pr0 * 2048 + off), (LAS unsigned*)(stg + wid * 1024), 16, 0, 2);
        if (R == 2) __builtin_amdgcn_global_load_lds((const unsigned*)(src + (size_t)pr1 * 2048 + off), (LAS unsigned*)(stg + 8192 + wid * 1024), 16, 0, 2);
    }
    f32x4 d0, d1;
    __device__ __forceinline__ void rd() {
        d0 = *(const LAS f32x4*)(stg + off * 4u); if (R == 2) d1 = *(const LAS f32x4*)(stg + 8192 + off * 4u);
    }
    __device__ __forceinline__ void wr() {
        __builtin_nontemporal_store(d0, (f32x4*)(dst + (size_t)pr0 * 2048 + off)); if (R == 2) __builtin_nontemporal_store(d1, (f32x4*)(dst + (size_t)pr1 * 2048 + off));
    }
    __device__ __forceinline__ void flush() {
        for (int r = row; r < row_end; ++r) __builtin_nontemporal_store(__builtin_nontemporal_load((const f32x4*)(src + (size_t)r * 2048 + off)), (f32x4*)(dst + (size_t)r * 2048 + off));
    }
};
constexpr int COPY_ROWS = 511, COPY_R1 = 92, COPY_P3 = 202, COPY_P5 = 289, COPY_P6 = 353, COPY_P7 = 445, COPY_P7B = 467;
#ifndef REP_MASK
#define REP_MASK 0
#endif
#define REPS(n) (1 + ((REP_MASK >> (n)) & 1))
#define WSP(T, off) ((T*)(karg_ws() + (off)))
__global__ void __launch_bounds__(NTHREADS, 2) hymba_fwd(Args args_unused) {
    extern __shared__ __attribute__((aligned(16))) unsigned char lds_raw[];
    LAS unsigned char* lds = (LAS unsigned char*)lds_raw;
    const int tid = threadIdx.x, lane = tid & 63, wave = __builtin_amdgcn_readfirstlane(tid >> 6);
    const int G = gridDim.x; const int bx = blockIdx.x;
    const int vcu = (G % 8 == 0) ? (bx % 8) * (G / 8) + bx / 8 : bx;
    volatile LAS unsigned* MISC = (volatile LAS unsigned*)(lds + MISC_OFF);
    if (tid < 64) MISC[tid] = 0u;
    __syncthreads();
    XcdBarrier bar = xcd_barrier_post(WSP(unsigned, WS_CTL) + CW_BAR, MISC + 8);
#define GRID_BAR() do { XcdBarrier b_ = bar; b_.bar = WSP(unsigned, WS_CTL) + CW_BAR; xcd_barrier(b_); } while (0)
    const int gw = vcu * NWAVES + wave, NGW = G * NWAVES;
    constexpr size_t QS = (size_t)M * 512;

    for (int rep = 0; rep < REPS(0); ++rep) {
        if (rep) GRID_BAR();
        P0Args a; a.xp = karg_in(0); a.xs = karg_in(1); a.ck = karg_in(2); a.cv = karg_in(3); a.w1in = karg_in(4); a.w1out = karg_in(5); a.ln1g = karg_in(6); a.ln1b = karg_in(7); a.win = karg_in(8); a.sguw = karg_in(9);
        a.oag = karg_in(13); a.obg = karg_in(14); a.wout = karg_in(15); a.ln2g = karg_in(16); a.ln2b = karg_in(17); a.w2in = karg_in(18); a.w2out = karg_in(19);
        a.W1F8 = WSP(bf16, WS_W1F8); a.W2I8 = WSP(bf16, WS_W1IN); a.W1IN = nullptr; a.XF8 = WSP(unsigned char, WS_XF8); a.W1O8 = WSP(bf16, WS_W1O8); a.W2O8 = WSP(bf16, WS_W2O8); a.XS = WSP(float, WS_XS); a.W1OUT = WSP(bf16, WS_W1OUT); a.WIN = WSP(bf16, WS_WIN); a.WOUT = WSP(bf16, WS_WOUT); a.W2IN = WSP(bf16, WS_W2IN); a.W2OUT = WSP(bf16, WS_W2OUT);
        a.SGUW = WSP(bf16, WS_SGUW); a.XB = WSP(bf16, WS_XB); a.VECP = WSP(float, WS_VECP); a.out = karg_out();
        p0_prologue(a, lds, vcu, G, tid);
    }
    GRID_BAR();
    for (int rep = 0; rep < REPS(1); ++rep) {
        if (rep) GRID_BAR();
        vec_reduce(WSP(float, WS_VECP), WSP(float, WS_VEC), vcu * NTHREADS + tid, G * NTHREADS);
#ifndef F8P1
#define F8P1 24
#endif
#ifndef F8P
#define F8P 16
#endif
        {
            pg8::EpiSwiGLU<false, true> E{WSP(bf16, WS_H), nullptr, nullptr, nullptr, WSP(unsigned char, WS_H8), F8P1, WSP(float, WS_XS), WSP(float, WS_XS) + M};
            pg8::Gemm g{WSP(bf16, WS_XF8), WSP(bf16, WS_W1F8), M, NFF2, DM / 2, 1, 1}; pg8::StaticOrder S; S.init(M, NFF2, G, bx);
            CopyHook<1> hk; hk.init(karg_in(2), karg_in(3), karg_out(), WSP(float, WS_CTL + 512 * 1024), lds + CPY_OFF, bx, 0, COPY_R1, tid);
            pg8::gemm_phase<pg8::EpiSwiGLU<false, true>, pg8::StaticOrder, true, true, CopyHook<1>, 2>(lds, g, S, E, hk);
        }
    }
    GRID_BAR();
    for (int rep = 0; rep < REPS(2); ++rep) {
        if (rep) GRID_BAR();
        pg8::EpiRes<2, true> E{(const bf16*)karg_in(0), nullptr, nullptr, nullptr, WSP(bf16, WS_ZB), WSP(float, WS_ST1), 0.5f};
        constexpr int T8 = (F8P1 * 8 * 4 / 256) * 11, T16 = ((32 - F8P1) * 8 * 4 / 256) * 22;
        {
            pg8::Gemm g{WSP(bf16, WS_H8), WSP(bf16, WS_W1O8), MP, DM, DFF / 2, 1, 1}; pg8::RangeOrder<0, F8P1> S; S.init_sub(DM, G, bx);
            CopyHook<2> hk; hk.init(karg_in(2), karg_in(3), karg_out(), WSP(float, WS_CTL + 512 * 1024), lds + CPY_OFF, bx, COPY_R1, COPY_R1 + 2 * T8, tid);
            pg8::gemm_phase<pg8::EpiRes<2, true>, pg8::RangeOrder<0, F8P1>, true, true, CopyHook<2>, 1>(lds, g, S, E, hk);
        }
        {
            pg8::Gemm g{WSP(bf16, WS_H), WSP(bf16, WS_W1OUT), MP, DM, DFF, 1, 1}; pg8::RangeOrder<F8P1, 32> S; S.init_sub(DM, G, bx);
            CopyHook<2> hk; hk.init(karg_in(2), karg_in(3), karg_out(), WSP(float, WS_CTL + 512 * 1024), lds + CPY_OFF, bx, COPY_R1 + 2 * T8, COPY_R1 + 2 * T8 + 2 * T16, tid);
            pg8::gemm_phase<pg8::EpiRes<2, true>, pg8::RangeOrder<F8P1, 32>, true, true, CopyHook<2>, 0>(lds, g, S, E, hk);
        }
        for (int su = vcu; su < 256; su += G) small_res_unit<0, true, true>(lds, WSP(bf16, WS_H), WSP(bf16, WS_W1OUT), DFF, su >> 4, su & 15, WSP(bf16, WS_XB), nullptr, nullptr, nullptr, WSP(bf16, WS_ZB), WSP(float, WS_ST1), 0.5f, tid);
        if (G < 2 * DECB) {
            const float* ck = karg_in(2); const float* cv = karg_in(3); float* out = karg_out();
            for (int seg = bx + G; seg < 2 * DECB; seg += G) { CopyHook<1> h2; h2.init(ck, cv, out, nullptr, lds + CPY_OFF, seg, 0, COPY_ROWS, tid); h2.flush(); }
        }
    }
    GRID_BAR();
    {
        const float* st1 = WSP(float, WS_ST1); float* pr1 = WSP(float, WS_Z);
        for (int row = vcu * NTHREADS + tid; row < M; row += G * NTHREADS) { float mean, rstd; pg8::combine16(st1 + (size_t)row * 32, mean, rstd); pg8::f32x2v ab; ab.x = mean; ab.y = rstd; *(pg8::f32x2v*)(pr1 + 2 * (size_t)row) = ab; }
    }
    GRID_BAR();
    for (int rep = 0; rep < REPS(3); ++rep) {
        if (rep) GRID_BAR();
        pg8::Gemm g{WSP(bf16, WS_ZB), WSP(bf16, WS_WIN), M, NIN, DM, 0, 1}; pg8::StaticOrder S; S.init(M, NIN, G, bx);
        float* out = karg_out();
        pg8::EpiQKV E{WSP(bf16, WS_QKV), WSP(float, WS_Z), WSP(float, WS_VEC), WSP(float, WS_VEC) + NIN, out + OUT_CKP, out + OUT_CVP, out + OUT_CKS, out + OUT_CVS};
        CopyHook<1> hk; hk.init(karg_in(2), karg_in(3), out, WSP(float, WS_CTL + 512 * 1024), lds + CPY_OFF, bx, COPY_P3, COPY_P5, tid);
        pg8::gemm_phase<pg8::EpiQKV, pg8::StaticOrder, true, true, CopyHook<1> >(lds, g, S, E, hk);
    }
    GRID_BAR();
    for (int rep = 0; rep < REPS(4); ++rep) {
        if (rep) GRID_BAR();
        for (int r2 = 0; r2 < REPS(10); ++r2) {
            const bf16* QB = WSP(bf16, WS_QKV); bf16* OP = WSP(bf16, WS_H); float* LSE = WSP(float, WS_LSE);
#define ATT_DEC(u_, h_, b_, g_, dil_, r_, blk_) const int h_ = (u_) & 7, x_##u_ = (u_) >> 3, bl_##u_ = x_##u_ & 31, g_ = (x_##u_ >> 5) % 3, b_ = (x_##u_ >> 5) / 3; const int dil_ = 1 << (2 * g_), nb_##u_ = 32 / dil_, r_ = bl_##u_ / nb_##u_, blk_ = bl_##u_ % nb_##u_;
            constexpr int NU = NBATCH * 3 * 32 * NH;
            AttnKV R;
            if (vcu < NU) { const int u0 = vcu; ATT_DEC(u0, h0, b0, g0, dil0, r0, blk0) (void)g0; attn_issue(R, QB, QB + QS, QB + 2 * QS, b0, dil0, r0, blk0, h0, tid); }
            for (int u = vcu; u < NU; u += G) {
                ATT_DEC(u, h, b, g, dil, r, blk)
                attn_fill(lds, R, tid);
                const bf16x8 qcur[4] = {R.qf[0], R.qf[1], R.qf[2], R.qf[3]};
                __syncthreads();
                const int un = u + G;
                if (un < NU) { ATT_DEC(un, hn, bn, gn, diln, rn, blkn) (void)gn; attn_issue(R, QB, QB + QS, QB + 2 * QS, bn, diln, rn, blkn, hn, tid); }
                attn_compute(lds, qcur, OP + (size_t)g * QS, LSE + (size_t)g * M * 8, b, dil, r, blk, h, tid);
            }
#undef ATT_DEC
        }
        for (int r2 = 0; r2 < REPS(11); ++r2) {
            const bf16* QB = WSP(bf16, WS_QKV);
            for (int c = vcu; c < MP / 128; c += G) sgu_unit(lds, QB + 3 * QS, QB + 4 * QS, WSP(bf16, WS_SGUW), karg_in(10), karg_in(11), karg_in(12), WSP(bf16, WS_XB), c, tid);
        }
        for (int r2 = 0; r2 < REPS(12); ++r2) {
            const bf16* QB = WSP(bf16, WS_QKV);
            int ln = threadIdx.x & 63; asm volatile("" : "+v"(ln));
            for (int t = gw; t < DECB * NH * DECS; t += NGW) decode_task(QB, QB + QS, QB + 2 * QS, karg_in(2), karg_in(3), WSP(bf16, WS_H), t >> 5, (t >> 2) & 7, t & 3, ln);
            for (int b = gw; b < DECB; b += NGW) sgu_sample(QB + 3 * QS, QB + 4 * QS, karg_in(9), karg_in(10), karg_in(11), karg_in(12), WSP(bf16, WS_XB), karg_out() + OUT_SGV, b, ln);
        }
    }
    GRID_BAR();
    for (int rep = 0; rep < REPS(9); ++rep) {
        if (rep) GRID_BAR();
        const bf16* OP = WSP(bf16, WS_H); const float* LSE = WSP(float, WS_LSE); bf16* OAB = WSP(bf16, WS_XB);
        int lnb = threadIdx.x & 63; asm volatile("" : "+v"(lnb));
        for (size_t row = gw; row < (size_t)M; row += 4 * (size_t)NGW) {
            CombIn I[4];
#pragma unroll
            for (int q = 0; q < 4; ++q) { const size_t rq = row + (size_t)q * NGW; if (rq < (size_t)M) combine_load(I[q], OP, LSE, rq, lnb); }
#pragma unroll
            for (int q = 0; q < 4; ++q) { const size_t rq = row + (size_t)q * NGW; if (rq < (size_t)M) combine_finish(I[q], OAB, rq, lnb); }
        }
    }
    GRID_BAR();
    for (int rep = 0; rep < REPS(5); ++rep) {
        if (rep) GRID_BAR();
        pg8::Gemm g{WSP(bf16, WS_XB), WSP(bf16, WS_WOUT), MP, DM, DM, 0, 1}; pg8::StaticOrder S; S.init(MP, DM, G, bx);
        pg8::EpiRes<1, true> E{WSP(bf16, WS_ZB), WSP(float, WS_Z), karg_in(6), karg_in(7), WSP(bf16, WS_ZB), WSP(float, WS_ST2), 1.0f};
        CopyHook<2> hk; hk.init(karg_in(2), karg_in(3), karg_out(), WSP(float, WS_CTL + 512 * 1024), lds + CPY_OFF, bx, COPY_P5, COPY_P6, tid);
        pg8::gemm_phase<pg8::EpiRes<1, true>, pg8::StaticOrder, true, true, CopyHook<2> >(lds, g, S, E, hk);
        for (int su = vcu; su < 256; su += G) small_res_unit<1, true, false>(lds, WSP(bf16, WS_XB), WSP(bf16, WS_WOUT), DM, su >> 4, su & 15, WSP(bf16, WS_ZB), WSP(float, WS_ST1), karg_in(6), karg_in(7), WSP(bf16, WS_ZB), WSP(float, WS_ST2), 1.0f, tid);
    }
    GRID_BAR();
    for (int rep = 0; rep < REPS(9); ++rep) {
        if (rep) GRID_BAR();
        const bf16* zb = WSP(bf16, WS_ZB); unsigned char* zi = WSP(unsigned char, WS_XF8); float* zs = WSP(float, WS_XS) + M + 2 * NFF2; const float* st2 = WSP(float, WS_ST2); float* pr2 = WSP(float, WS_Z + MiB);
        int lnq = threadIdx.x & 63; asm volatile("" : "+v"(lnq));
        for (size_t row = gw; row < (size_t)M; row += 4 * (size_t)NGW) {
            u32x4 v[4][2];
#pragma unroll
            for (int q = 0; q < 4; ++q) { const size_t rq = row + (size_t)q * NGW; if (rq < (size_t)M) { v[q][0] = *(const u32x4*)(zb + rq * DM + 8 * lnq); v[q][1] = *(const u32x4*)(zb + rq * DM + 512 + 8 * lnq); } }
#pragma unroll
            for (int q = 0; q < 4; ++q) { const size_t rq = row + (size_t)q * NGW; if (rq < (size_t)M) {
                float f[2][8]; unpack8(v[q][0], f[0]); unpack8(v[q][1], f[1]);
                float mean, rstd; pg8::combine16(st2 + rq * 32, mean, rstd);
                float am = 0.f;
#pragma unroll
                for (int e = 0; e < 8; ++e) { f[0][e] = (f[0][e] - mean) * rstd; f[1][e] = (f[1][e] - mean) * rstd; am = fmaxf(am, fmaxf(fabsf(f[0][e]), fabsf(f[1][e]))); }
                am = wave_max(am);
                const float inv = am > 0.f ? 127.0f / am : 0.f;
                if (lnq == 0) { pg8::f32x2v ab; ab.x = am * (1.0f / 127.0f); ab.y = 0.f; *(pg8::f32x2v*)(zs + 2 * rq) = ab; ab.x = mean; ab.y = rstd; *(pg8::f32x2v*)(pr2 + 2 * rq) = ab; }
                unsigned char* dst = zi + (rq >> 8) * ((size_t)256 * DM) + (rq & 255) * 128 + (size_t)(lnq >> 4) * (256 * 128) + 8 * (lnq & 15);
#pragma unroll
                for (int h = 0; h < 2; ++h) { u32x2 o; o.x = pk4_i8(f[h][0] * inv, f[h][1] * inv, f[h][2] * inv, f[h][3] * inv); o.y = pk4_i8(f[h][4] * inv, f[h][5] * inv, f[h][6] * inv, f[h][7] * inv);
                    *(u32x2*)(dst + (size_t)h * (4 * 256 * 128)) = o; }
            } }
        }
    }
    GRID_BAR();
    for (int rep = 0; rep < REPS(6); ++rep) {
        if (rep) GRID_BAR();
        pg8::Gemm g{WSP(bf16, WS_XF8), WSP(bf16, WS_W1IN), M, NFF2, DM / 2, 1, 1}; pg8::StaticOrder S; S.init(M, NFF2, G, bx);
        pg8::EpiSwiGLU<true, true> E{WSP(bf16, WS_H), WSP(float, WS_ST2), WSP(float, WS_VEC) + 2 * NIN, WSP(float, WS_VEC) + 2 * NIN + NFF2, WSP(unsigned char, WS_H8), F8P, WSP(float, WS_XS) + M + 2 * NFF2, WSP(float, WS_XS) + M + NFF2};
        { CopyHook<1> hk; hk.init(karg_in(2), karg_in(3), karg_out(), WSP(float, WS_CTL + 512 * 1024), lds + CPY_OFF, bx, COPY_P6, COPY_P7, tid);
          pg8::gemm_phase<pg8::EpiSwiGLU<true, true>, pg8::StaticOrder, true, true, CopyHook<1>, 2>(lds, g, S, E, hk); }
    }
    GRID_BAR();
    for (int rep = 0; rep < REPS(7); ++rep) {
        if (rep) GRID_BAR();
        pg8::EpiRes<1, false> E{WSP(bf16, WS_ZB), WSP(float, WS_Z + MiB), karg_in(16), karg_in(17), WSP(bf16, WS_ZB), nullptr, 0.5f};
        constexpr int T8 = (F8P * 8 * 4 / 256) * 11;
        {
            pg8::Gemm g{WSP(bf16, WS_H8), WSP(bf16, WS_W2O8), MP, DM, DFF / 2, 1, 1}; pg8::RangeOrder<0, F8P> S; S.init_sub(DM, G, bx);
            CopyHook<1> hk; hk.init(karg_in(2), karg_in(3), karg_out(), WSP(float, WS_CTL + 512 * 1024), lds + CPY_OFF, bx, COPY_P7, COPY_P7B, tid);
            pg8::gemm_phase<pg8::EpiRes<1, false>, pg8::RangeOrder<0, F8P>, true, true, CopyHook<1>, 1>(lds, g, S, E, hk);
        }
        {
            pg8::Gemm g{WSP(bf16, WS_H), WSP(bf16, WS_W2OUT), MP, DM, DFF, 1, 1}; pg8::RangeOrder<F8P, 32> S; S.init_sub(DM, G, bx);
            CopyHook<1> hk; hk.init(karg_in(2), karg_in(3), karg_out(), WSP(float, WS_CTL + 512 * 1024), lds + CPY_OFF, bx, COPY_P7B, COPY_ROWS, tid);
            pg8::gemm_phase<pg8::EpiRes<1, false>, pg8::RangeOrder<F8P, 32>, true, true, CopyHook<1>, 0>(lds, g, S, E, hk);
        }
        for (int su = vcu; su < 256; su += G) small_res_unit<1, false, true>(lds, WSP(bf16, WS_H), WSP(bf16, WS_W2OUT), DFF, su >> 4, su & 15, WSP(bf16, WS_ZB), WSP(float, WS_ST2), karg_in(16), karg_in(17), WSP(bf16, WS_ZB), nullptr, 0.5f, tid);
    }
    GRID_BAR();
    for (int rep = 0; rep < REPS(8); ++rep) {
        if (rep) GRID_BAR();
        float* y = karg_out() + OUT_Y; const float* g3 = karg_in(20); const float* b3 = karg_in(21); const bf16* z3 = WSP(bf16, WS_ZB);
        int ln8 = threadIdx.x & 63; asm volatile("" : "+v"(ln8));
        for (size_t row = gw; row < (size_t)M; row += 4 * (size_t)NGW) {
            LnIn I[4];
#pragma unroll
            for (int q = 0; q < 4; ++q) { const size_t rq = row + (size_t)q * NGW; if (rq < (size_t)M) final_ln_load(I[q], z3 + rq * DM, ln8); }
#pragma unroll
            for (int q = 0; q < 4; ++q) { const size_t rq = row + (size_t)q * NGW; if (rq < (size_t)M) final_ln_finish(I[q], y + rq * DM, g3, b3, ln8); }
        }
    }
}

extern "C" void kernel_launch(void* const* d_in, const int* in_sizes, int n_in, void* d_out, int out_size, void* d_ws, size_t ws_size, hipStream_t stream) {
    static int grid = 0;
    if (grid == 0) {
        if (n_in != 22 || (size_t)out_size != OUT_TOTAL || ws_size < WS_END) { fprintf(stderr, "kernel_launch: unexpected shapes (n_in %d, out %d, ws %zu); nothing launched\n", n_in, out_size, ws_size); grid = -1; return; }
        int dev = 0, cus = 0;
        if (hipGetDevice(&dev) != hipSuccess || hipDeviceGetAttribute(&cus, hipDeviceAttributeMultiprocessorCount, dev) != hipSuccess || cus <= 0) { fprintf(stderr, "kernel_launch: device query failed\n"); grid = -1; return; }
        if (hipFuncSetAttribute((const void*)hymba_fwd, hipFuncAttributeMaxDynamicSharedMemorySize, LDS_BYTES) != hipSuccess) { fprintf(stderr, "kernel_launch: hipFuncSetAttribute failed\n"); grid = -1; return; }
        int per_cu = 0;
        if (hipOccupancyMaxActiveBlocksPerMultiprocessor(&per_cu, (const void*)hymba_fwd, NTHREADS, LDS_BYTES) != hipSuccess || per_cu < 1) { fprintf(stderr, "kernel_launch: occupancy query reports %d workgroups per CU\n", per_cu); }
        (void)hipGetLastError();
        grid = cus;
    }
    if (grid < 0) return;
    if (hipMemsetAsync((char*)d_ws + WS_CTL, 0, CTL_ZERO_BYTES, stream) != hipSuccess) { fprintf(stderr, "kernel_launch: memset failed\n"); return; }
    Args a{};
    for (int i = 0; i < 22; ++i) a.in[i] = (const float*)d_in[i];
    a.out = (float*)d_out; a.ws = (unsigned char*)d_ws;
    hipLaunchKernelGGL(hymba_fwd, dim3(grid), dim3(NTHREADS), LDS_BYTES, stream, a);
    const hipError_t le = hipPeekAtLastError();
    if (le != hipSuccess) fprintf(stderr, "kernel_launch: launch failed: %s\n", hipGetErrorName(le));
}
```

```cpp
#include <hip/hip_runtime.h>
#include <cstdio>
#include <cstdint>
namespace pg8 {
#define PG8_LAS __attribute__((address_space(3)))
typedef unsigned short bf16_t;
typedef short bf16x8 __attribute__((ext_vector_type(8)));
typedef float f32x4 __attribute__((ext_vector_type(4)));
typedef unsigned u32x4 __attribute__((ext_vector_type(4)));
typedef int v8i_t __attribute__((ext_vector_type(8)));
typedef int v4i_t __attribute__((ext_vector_type(4)));
constexpr int BM = 256, BK = 64, HALF = 128, HTB = HALF * BK * 2  , STAGE_BYTES = 8 * HTB, NXCD = 8, WGM = 8;

__host__ __device__ __forceinline__ int lds_byte(int r, int c) { const int st = (r >> 4) * 2 + (c >> 5), rr = r & 15, cc = c & 31, ob = rr * 64 + cc * 2; return st * 1024 + (ob ^ (((ob >> 9) & 1) << 5)); }
__host__ __device__ __forceinline__ void stage_rc(int b, int& R, int& C) { const int st = b / 1024, sb = b % 1024, swz = sb ^ (((sb >> 9) & 1) << 5); R = (st >> 1) * 16 + swz / 64; C = (st & 1) * 32 + (swz % 64) / 2; }
__host__ __device__ __forceinline__ int perm32(int rho) { const int n = rho >> 4, i = rho & 15; return 8 * (i >> 2) + 4 * n + (i & 3); }

struct Unit { int pm, pn; };
struct Gemm { const bf16_t* A; const bf16_t* Bt; int M, N, K; int atile, btile; };

struct StaticOrder {
    int nM, nN, nwg, G, c;
    __host__ __device__ void init(int M, int N, int G_, int c_) { nM = M / BM; nN = N / BM; nwg = nM * nN; G = G_; c = c_; }
    __host__ __device__ bool next(int i, Unit& u) const {
        const long L = (long)i * G + c; if (L >= nwg) return false;
        int wgid = (int)L; { const int q = nwg / NXCD, r = nwg % NXCD, xcd = wgid % NXCD, off = wgid / NXCD; wgid = (xcd < r ? xcd * (q + 1) : r * (q + 1) + (xcd - r) * q) + off; }
        const int nig = WGM * nN, gid = wgid / nig, fm = gid * WGM, gsz = (nM - fm) < WGM ? (nM - fm) : WGM;
        u.pm = fm + ((wgid % nig) % gsz); u.pn = (wgid % nig) / gsz; return true;
    }
    __device__ __forceinline__ void a_ready(const Unit&) const {}
    __device__ __forceinline__ void done(const Unit&) const {}
};
template <int KIND> struct SubsetOrder : StaticOrder {
    __host__ __device__ void init_sub(int N, int G_, int c_) { StaticOrder::init((KIND == 0 ? 128 : 130) * BM, N, G_, c_); }
    __host__ __device__ bool next(int i, Unit& u) const {
        if (!StaticOrder::next(i, u)) return false;
        const int v = u.pm; u.pm = (KIND == 0) ? ((v >> 4) * 32 + (v & 15)) : (v < 128 ? ((v >> 4) * 32 + 16 + (v & 15)) : (256 + (v - 128)));
        return true;
    }
};
template <int LO, int HI> struct RangeOrder : StaticOrder {
    __host__ __device__ void init_sub(int N, int G_, int c_) { StaticOrder::init((HI - LO) * 8 * BM, N, G_, c_); }
    __host__ __device__ bool next(int i, Unit& u) const {
        if (!StaticOrder::next(i, u)) return false;
        const int v = u.pm; u.pm = (v / (HI - LO)) * 32 + LO + (v % (HI - LO));
        return true;
    }
};
typedef float f32x2c_t __attribute__((ext_vector_type(2))); typedef __bf16 bf16x2c_t __attribute__((ext_vector_type(2)));
__device__ __forceinline__ unsigned cvt_pk_bf16(float lo, float hi) { const f32x2c_t v = {lo, hi}; const bf16x2c_t b = __builtin_convertvector(v, bf16x2c_t); return __builtin_bit_cast(unsigned, b); }
typedef float f32x2 __attribute__((ext_vector_type(2)));
typedef float f32x2v __attribute__((ext_vector_type(2)));
typedef unsigned u32x2v __attribute__((ext_vector_type(2)));
constexpr int MP = 65536, MS = 512, MTOT = MP + MS;
constexpr float LN_EPS = 1e-5f;
constexpr float DN_ALPHA = 1.189207115002721f;
constexpr float QSCALE = 0.125f * 1.4426950408889634f;

__device__ __forceinline__ void combine16(const float* st, float& mean, float& rstd) {
    f32x4 p[8];
#pragma unroll
    for (int i = 0; i < 8; ++i) p[i] = *(const f32x4*)(st + 4 * i);
    float ms = 0.f;
#pragma unroll
    for (int i = 0; i < 8; ++i) ms += p[i][0] + p[i][2];
    mean = ms * (1.0f / 16.0f);
    float q = 0.f;
#pragma unroll
    for (int i = 0; i < 8; ++i) { const float d0 = p[i][0] - mean, d1 = p[i][2] - mean; q += (p[i][1] + p[i][3]) + 64.0f * (d0 * d0 + d1 * d1); }
    rstd = 1.0f / sqrtf(q * (1.0f / 1024.0f) + LN_EPS);
}
__device__ __forceinline__ void lane_row_stats(const float* PR, int rowbase, int fr, int fq, float (&mean)[8], float (&rstd)[8]) {
#pragma unroll
    for (int k = 0; k < 8; ++k) { const f32x2v ab = *(const f32x2v*)(PR + 2 * (size_t)(rowbase + (k >> 2) * 128 + (k & 3) * 16)); mean[k] = ab.x; rstd[k] = ab.y; }
}
__device__ __forceinline__ void lane_row_stats4(const float* ST, int rowbase, int fr, int fq, float (&mean)[4], float (&rstd)[4]) {
    float m1, r1; combine16(ST + (size_t)(rowbase + fq * 16) * 32, m1, r1);
#pragma unroll
    for (int m = 0; m < 4; ++m) { mean[m] = __shfl(m1, fr + 16 * m); rstd[m] = __shfl(r1, fr + 16 * m); }
}
__device__ __forceinline__ unsigned pk4_fp8e(float a, float b, float c, float d) { int w = __builtin_amdgcn_cvt_pk_fp8_f32(a, b, 0, false); w = __builtin_amdgcn_cvt_pk_fp8_f32(c, d, w, true); return (unsigned)w; }
__device__ __forceinline__ float bf2f(unsigned short b) { return __uint_as_float((unsigned)b << 16); }
__device__ __forceinline__ float bflo(unsigned w) { return __uint_as_float(w << 16); }
__device__ __forceinline__ float bfhi(unsigned w) { return __uint_as_float(w & 0xffff0000u); }

typedef __amdgpu_buffer_rsrc_t rsrc_t;
__device__ __forceinline__ rsrc_t mk_rsrc(const void* p, unsigned bytes) { return __builtin_amdgcn_make_buffer_rsrc((void*)p, 0, bytes, 0x00020000); }
__device__ __forceinline__ u32x4 bload16(rsrc_t r, unsigned voff, unsigned soff) { return __builtin_bit_cast(u32x4, __builtin_amdgcn_raw_buffer_load_b128(r, voff, soff, 0)); }
__device__ __forceinline__ void bstore16(rsrc_t r, unsigned voff, unsigned soff, u32x4 v) { __builtin_amdgcn_raw_buffer_store_b128(v, r, voff, soff, 0); }
__device__ __forceinline__ void bstore16f(rsrc_t r, unsigned voff, unsigned soff, f32x4 v) { __builtin_amdgcn_raw_buffer_store_b128(__builtin_bit_cast(u32x4, v), r, voff, soff, 0); }
__device__ __forceinline__ void bstore8f(rsrc_t r, unsigned voff, unsigned soff, f32x2v v) { __builtin_amdgcn_raw_buffer_store_b64(__builtin_bit_cast(u32x2v, v), r, voff, soff, 0); }

template <int MODE, bool STATS> struct EpiRes {
    static constexpr bool PERM = true, AFTER_DRAIN = false;
    const bf16_t* rsrc; const float* stprev; const float* g; const float* b; bf16_t* zb; float* stout; float scale;
    __device__ __forceinline__ void operator()(const f32x4 (&acc)[2][2][4][2], const Unit& u, int wr, int wc, int fr_in, int fq_in) const {
        int fr = fr_in, fq = fq_in; asm volatile("" : "+v"(fr), "+v"(fq));
        const int rowU = u.pm * BM + wr * 64, colU = u.pn * BM + wc * 32;
        const unsigned voff = (unsigned)(fr * 1024 + 8 * fq) * 2u;
        const unsigned sbase = (unsigned)(rowU * 1024 + colU) * 2u;
        const rsrc_t rR = (MODE == 2) ? mk_rsrc((const float*)rsrc + (size_t)(u.pm >> 5) * (8192 * 1024), 8192u * 4096u) : mk_rsrc(rsrc, (unsigned)MTOT * 2048u);
        const rsrc_t rZ = mk_rsrc(zb, (unsigned)MTOT * 2048u), rS = mk_rsrc(stout, (unsigned)MTOT * 128u);
        const unsigned sbase4 = (unsigned)(((u.pm & 31) * BM + wr * 64) * 1024 + colU) * 4u;
        float mean[8], rstd[8]; f32x4 gv[2][2], bv[2][2];
        if (MODE == 1) {
            lane_row_stats(stprev, rowU + fr, fr, fq, mean, rstd);
#pragma unroll
            for (int bj = 0; bj < 2; ++bj)
#pragma unroll
                for (int n = 0; n < 2; ++n) { gv[bj][n] = *(const f32x4*)(g + colU + bj * HALF + 4 * n + 8 * fq); bv[bj][n] = *(const f32x4*)(b + colU + bj * HALF + 4 * n + 8 * fq); }
        }
#pragma unroll
        for (int ai = 0; ai < 2; ++ai)
#pragma unroll
            for (int m = 0; m < 4; ++m) {
                const int k = ai * 4 + m; const unsigned so = sbase + (unsigned)((ai * HALF + m * 16) * 1024) * 2u;
                u32x4 raw[2], raw2[2];
                if (MODE == 2) { const unsigned so4 = sbase4 + (unsigned)((ai * HALF + m * 16) * 1024) * 4u;
#pragma unroll
                    for (int bj = 0; bj < 2; ++bj) { raw[bj] = bload16(rR, 2u * voff, so4 + bj * (HALF * 4)); raw2[bj] = bload16(rR, 2u * voff, so4 + bj * (HALF * 4) + 16u); } }
                else {
#pragma unroll
                for (int bj = 0; bj < 2; ++bj) raw[bj] = bload16(rR, voff, so + bj * (HALF * 2));
                }
                f32x4 z[2][2]; float s = 0.f;
#pragma unroll
                for (int bj = 0; bj < 2; ++bj) {
                    const u32x4 w = raw[bj];
                    f32x4 r0 = (f32x4){bflo(w.x), bfhi(w.x), bflo(w.y), bfhi(w.y)}, r1 = (f32x4){bflo(w.z), bfhi(w.z), bflo(w.w), bfhi(w.w)};
                    if (MODE == 2) { r0 = __builtin_bit_cast(f32x4, raw[bj]); r1 = __builtin_bit_cast(f32x4, raw2[bj]); }
                    if (MODE == 1) { r0 = (r0 - mean[k]) * rstd[k] * gv[bj][0] + bv[bj][0]; r1 = (r1 - mean[k]) * rstd[k] * gv[bj][1] + bv[bj][1]; }
                    z[bj][0] = r0 * DN_ALPHA + acc[ai][bj][m][0] * scale; z[bj][1] = r1 * DN_ALPHA + acc[ai][bj][m][1] * scale;
                    s += ((z[bj][0][0] + z[bj][0][1]) + (z[bj][0][2] + z[bj][0][3])) + ((z[bj][1][0] + z[bj][1][1]) + (z[bj][1][2] + z[bj][1][3]));
                }
                if (STATS) {
                    s += __shfl_xor(s, 16); s += __shfl_xor(s, 32);
                    const float mw = s * (1.0f / 64.0f); float q = 0.f;
#pragma unroll
                    for (int bj = 0; bj < 2; ++bj)
#pragma unroll
                        for (int n = 0; n < 2; ++n) { const f32x4 d = z[bj][n] - mw; q += (d[0] * d[0] + d[1] * d[1]) + (d[2] * d[2] + d[3] * d[3]); }
                    q += __shfl_xor(q, 16); q += __shfl_xor(q, 32);
                    if (fq == 0) bstore8f(rS, (unsigned)fr * 128u, (unsigned)((rowU + ai * HALF + m * 16) * 32 + (u.pn * 4 + wc) * 2) * 4u, (f32x2v){mw, q});
                }
#pragma unroll
                for (int bj = 0; bj < 2; ++bj) {
                    u32x4 w; w.x = cvt_pk_bf16(z[bj][0][0], z[bj][0][1]); w.y = cvt_pk_bf16(z[bj][0][2], z[bj][0][3]); w.z = cvt_pk_bf16(z[bj][1][0], z[bj][1][1]); w.w = cvt_pk_bf16(z[bj][1][2], z[bj][1][3]);
                    bstore16(rZ, voff, so + bj * (HALF * 2), w);
                }
                asm volatile("" ::: "memory");
            }
    }
};

template <bool FOLD, bool I8IN = false> struct EpiSwiGLU {
    static constexpr bool PERM = true, AFTER_DRAIN = false;
    bf16_t* H; const float* st; const float* svec; const float* tvec; unsigned char* H8; int f8p; const float* xs; const float* wsc;
    __device__ __forceinline__ void operator()(const f32x4 (&acc)[2][2][4][2], const Unit& u, int wr, int wc, int fr, int fq) const {
        const int rowU = u.pm * BM + wr * 64, rhoU = u.pn * BM + wc * 32, hcolU = u.pn * HALF + wc * 32;
        const bool f8o = (H8 != nullptr) && (u.pm < 256) && ((u.pm & 31) < f8p);
        unsigned char* h8b = H8 + (size_t)u.pm * (BM * 2816) + (size_t)u.pn * (BM * 128) + (wr * 64) * 128 + wc * 32;
        const unsigned loff = (unsigned)(fr * 64 + 8 * fq);
        float mean[8], rstd[8]; f32x4 sv[2][2], tv[2][2];
        if (FOLD) {
            if (!I8IN) lane_row_stats(st, rowU + fr, fr, fq, mean, rstd);
#pragma unroll
            for (int bj = 0; bj < 2; ++bj)
#pragma unroll
                for (int n = 0; n < 2; ++n) { if (!I8IN) sv[bj][n] = *(const f32x4*)(svec + rhoU + bj * HALF + 4 * n + 8 * fq); tv[bj][n] = *(const f32x4*)(tvec + rhoU + bj * HALF + 4 * n + 8 * fq); }
        }
        float xr[8]; f32x4 wq[2][2];
        if (I8IN && FOLD) {
#pragma unroll
            for (int k8 = 0; k8 < 8; ++k8) xr[k8] = xs[2 * (size_t)(rowU + (k8 >> 2) * HALF + (k8 & 3) * 16 + fr)];
        }
        if (I8IN) {
            if (!FOLD) {
#pragma unroll
            for (int k8 = 0; k8 < 8; ++k8) xr[k8] = xs[rowU + (k8 >> 2) * HALF + (k8 & 3) * 16 + fr];
            }
#pragma unroll
            for (int bj = 0; bj < 2; ++bj)
#pragma unroll
                for (int n = 0; n < 2; ++n) wq[bj][n] = *(const f32x4*)(wsc + rhoU + bj * HALF + 4 * n + 8 * fq);
        }
        bf16_t* hb = H + (size_t)u.pm * (BM * 2816) + (size_t)(hcolU >> 6) * (BM * 64) + (wr * 64) * 64 + (hcolU & 63);
#pragma unroll
        for (int ai = 0; ai < 2; ++ai)
#pragma unroll
            for (int m = 0; m < 4; ++m) {
                const int k = ai * 4 + m;
                float hv[8];
#pragma unroll
                for (int n = 0; n < 2; ++n) {
                    f32x4 gt = acc[ai][0][m][n], up = acc[ai][1][m][n];
                    if (I8IN) { const v4i_t gi = __builtin_bit_cast(v4i_t, gt), ui = __builtin_bit_cast(v4i_t, up);
                        gt = (f32x4){(float)gi[0], (float)gi[1], (float)gi[2], (float)gi[3]} * xr[k] * wq[0][n]; up = (f32x4){(float)ui[0], (float)ui[1], (float)ui[2], (float)ui[3]} * xr[k] * wq[1][n]; }
                    if (FOLD && I8IN) { gt = gt + tv[0][n]; up = up + tv[1][n]; }
                    else if (FOLD) { gt = (gt - sv[0][n] * mean[k]) * rstd[k] + tv[0][n]; up = (up - sv[1][n] * mean[k]) * rstd[k] + tv[1][n]; }
#pragma unroll
                    for (int e = 0; e < 4; ++e) { const float sg = __builtin_amdgcn_rcpf(1.0f + __builtin_amdgcn_exp2f(gt[e] * -1.4426950408889634f)); hv[4 * n + e] = gt[e] * sg * up[e]; }
                }
                if (f8o) { u32x2v q; q.x = pk4_fp8e(hv[0], hv[1], hv[2], hv[3]); q.y = pk4_fp8e(hv[4], hv[5], hv[6], hv[7]);
                    *(u32x2v*)(h8b + (size_t)(ai * HALF + m * 16) * 128 + (unsigned)(fr * 128 + 8 * fq)) = q; }
                else {
                u32x4 w; w.x = cvt_pk_bf16(hv[0], hv[1]); w.y = cvt_pk_bf16(hv[2], hv[3]); w.z = cvt_pk_bf16(hv[4], hv[5]); w.w = cvt_pk_bf16(hv[6], hv[7]);
                __builtin_nontemporal_store(w, (u32x4*)(hb + (size_t)(ai * HALF + m * 16) * 64 + loff)); }
                asm volatile("" ::: "memory");
            }
    }
};

struct EpiQKV {
    static constexpr bool PERM = true, AFTER_DRAIN = false;
    bf16_t* qkv; const float* st; const float* svec; const float* tvec; float* ckp; float* cvp; float* cks; float* cvs;
    __device__ __forceinline__ void operator()(const f32x4 (&acc)[2][2][4][2], const Unit& u, int wr, int wc, int fr, int fq) const {
        const int rowU = u.pm * BM + wr * 64, rhoU = u.pn * BM + wc * 32;
        const int tsel = u.pn >> 1, dcolU = (u.pn & 1) * BM + wc * 32;
        bf16_t* dstU = qkv + (size_t)tsel * ((size_t)MTOT * 512) + (size_t)rowU * 512 + dcolU;
        const unsigned loff = (unsigned)(fr * 512 + 8 * fq);
        const float sc = (tsel == 0) ? QSCALE : 1.0f;
        float mean[8], rstd[8];
        lane_row_stats(st, rowU + fr, fr, fq, mean, rstd);
        int cmode = 0; float* cU = nullptr; size_t SA = 0, SM = 0; unsigned coffL = 0;
        if (tsel == 1 || tsel == 2) {
            if (u.pm < 256) { if ((u.pm & 31) >= 24) { cmode = 1; cU = ((tsel == 1) ? ckp : cvp) + ((size_t)(u.pm >> 5) * 2048 + (size_t)((u.pm & 31) - 24) * 256 + wr * 64) * 512 + dcolU; SA = (size_t)HALF * 512; SM = (size_t)16 * 512; coffL = (unsigned)(fr * 512 + 8 * fq); } }
            else { cmode = 2; cU = ((tsel == 1) ? cks : cvs) + ((size_t)((u.pm - 256) * 64 + wr * 16) * 2048 + 2044) * 512 + dcolU; SA = (size_t)32 * 2048 * 512; SM = (size_t)4 * 2048 * 512; coffL = (unsigned)(((fr >> 2) * 2048 + (fr & 3)) * 512 + 8 * fq); }
        }
        f32x4 sv[2][2], tv[2][2];
#pragma unroll
        for (int bj = 0; bj < 2; ++bj)
#pragma unroll
            for (int n = 0; n < 2; ++n) { sv[bj][n] = *(const f32x4*)(svec + rhoU + bj * HALF + 4 * n + 8 * fq); tv[bj][n] = *(const f32x4*)(tvec + rhoU + bj * HALF + 4 * n + 8 * fq); }
#pragma unroll
        for (int ai = 0; ai < 2; ++ai)
#pragma unroll
            for (int m = 0; m < 4; ++m) {
                const int k = ai * 4 + m;
                bf16_t* drow = dstU + (size_t)(ai * HALF + m * 16) * 512;
                float* crow = cU + ai * SA + m * SM;
#pragma unroll
                for (int bj = 0; bj < 2; ++bj) {
                    f32x4 v0 = (acc[ai][bj][m][0] - sv[bj][0] * mean[k]) * rstd[k] + tv[bj][0];
                    f32x4 v1 = (acc[ai][bj][m][1] - sv[bj][1] * mean[k]) * rstd[k] + tv[bj][1];
                    if (cmode != 0) { *(f32x4*)(crow + bj * HALF + coffL) = v0; *(f32x4*)(crow + bj * HALF + 4 + coffL) = v1; }
                    v0 = v0 * sc; v1 = v1 * sc;
                    u32x4 w; w.x = cvt_pk_bf16(v0[0], v0[1]); w.y = cvt_pk_bf16(v0[2], v0[3]); w.z = cvt_pk_bf16(v1[0], v1[1]); w.w = cvt_pk_bf16(v1[2], v1[3]);
                    if (tsel >= 3) __builtin_nontemporal_store(w, (u32x4*)(drow + bj * HALF + loff)); else *(u32x4*)(drow + bj * HALF + loff) = w;
                }
                asm volatile("" ::: "memory");
            }
    }
};
struct NoHook { static constexpr int EXTRA = 0; __device__ __forceinline__ void prime() {} __device__ __forceinline__ void ld() {} __device__ __forceinline__ void rd() {} __device__ __forceinline__ void wr() {} __device__ __forceinline__ void flush() {} };
template <class Epi, class Sched, bool ALIGN_EPI = false, bool SP2 = false, class HK = NoHook, int QM = 0>
__device__ __forceinline__ void gemm_phase(PG8_LAS unsigned char* lds, const Gemm g, const Sched& S, const Epi& E, HK& hk) {
    static_assert(HK::EXTRA == 0 || ((HK::EXTRA == 4 || HK::EXTRA == 2) && SP2), "side stream: 0, 2 or 4 operations per trip, SP2 loop only");
    int tid_l = threadIdx.x; asm volatile("" : "+v"(tid_l));
    const int tid = tid_l, wid = __builtin_amdgcn_readfirstlane(tid >> 6), lane = tid & 63, wr = wid >> 2, wc = wid & 3, fr = lane & 15, fq = lane >> 4;
    const int K = g.K, nt = K / BK;
    unsigned voffA[2], voffB[2];
#pragma unroll
    for (int i = 0; i < 2; ++i) { int R, C; stage_rc(tid * 16 + i * 8192, R, C); const int Rb = Epi::PERM ? ((R & ~31) + perm32(R & 31)) : R;
        voffA[i] = (unsigned)(R * (g.atile ? BK : K) + C) * 2u; voffB[i] = (unsigned)(Rb * (g.btile ? BK : K) + C) * 2u; }
    const size_t kstep = (size_t)(BK * 2);
    const size_t hstep = (size_t)HALF * K * 2;
    const size_t tstep = 2 * hstep;
    const size_t kstepA = g.atile ? (size_t)(BM * BK * 2) : kstep, hstepA = g.atile ? (size_t)(HALF * BK * 2) : hstep;
    const size_t kstepB = g.btile ? (size_t)(BM * BK * 2) : kstep, hstepB = g.btile ? (size_t)(HALF * BK * 2) : hstep;
    const unsigned ldsw = (unsigned)wid * 1024u;
    const int aoff = lds_byte(wr * 64 + fr, fq * 8), boff = lds_byte(wc * 32 + fr, fq * 8);
#define PG8_SA(b, h) (((b) * 2 + (h)) * HTB)
#define PG8_SB(b, h) ((4 + (b) * 2 + (h)) * HTB)
#define PG8_STAGE(bufoff, gbase, voff) do { _Pragma("unroll") for (int _i = 0; _i < 2; ++_i) \
        __builtin_amdgcn_global_load_lds((const unsigned*)((const char*)(gbase) + (voff)[_i]), (PG8_LAS unsigned*)(lds + (bufoff) + ldsw + _i * 8192), 16, 0, 0); } while (0)
#define PG8_LDA(dst, b, h) do { _Pragma("unroll") for (int m = 0; m < 4; ++m) _Pragma("unroll") for (int k = 0; k < 2; ++k) dst[m][k] = *(const PG8_LAS bf16x8*)(lds + PG8_SA(b, h) + aoff + m * 2048 + k * 1024); } while (0)
#define PG8_LDB(dst, b, h) do { _Pragma("unroll") for (int n = 0; n < 2; ++n) _Pragma("unroll") for (int k = 0; k < 2; ++k) dst[n][k] = *(const PG8_LAS bf16x8*)(lds + PG8_SB(b, h) + boff + n * 2048 + k * 1024); } while (0)
#define PG8_CAT8(lo, hi) __builtin_shufflevector(__builtin_bit_cast(v4i_t, lo), __builtin_bit_cast(v4i_t, hi), 0, 1, 2, 3, 4, 5, 6, 7)
#define PG8_MMA(ai, bj, At, Bt) do { __builtin_amdgcn_s_setprio(1); if constexpr (QM == 1) { _Pragma("unroll") for (int m = 0; m < 4; ++m) _Pragma("unroll") for (int n = 0; n < 2; ++n) { \
        const v8i_t b8_ = PG8_CAT8(Bt[n][0], Bt[n][1]), a8_ = PG8_CAT8(At[m][0], At[m][1]); \
        asm volatile("v_mfma_scale_f32_16x16x128_f8f6f4 %0, %1, %2, %0, %3, %4 op_sel_hi:[0,0,0]" : "+v"(acc[ai][bj][m][n]) : "v"(b8_), "v"(a8_), "v"(f8_sw), "v"(f8_sx)); } } else if constexpr (QM == 2) { \
        _Pragma("unroll") for (int m = 0; m < 4; ++m) _Pragma("unroll") for (int n = 0; n < 2; ++n) _Pragma("unroll") for (int k = 0; k < 2; ++k) \
        acc[ai][bj][m][n] = __builtin_bit_cast(f32x4, __builtin_amdgcn_mfma_i32_16x16x64_i8(__builtin_bit_cast(v4i_t, Bt[n][k]), __builtin_bit_cast(v4i_t, At[m][k]), __builtin_bit_cast(v4i_t, acc[ai][bj][m][n]), 0, 0, 0)); } else { \
        _Pragma("unroll") for (int m = 0; m < 4; ++m) _Pragma("unroll") for (int n = 0; n < 2; ++n) _Pragma("unroll") for (int k = 0; k < 2; ++k) \
        acc[ai][bj][m][n] = __builtin_amdgcn_mfma_f32_16x16x32_bf16(Bt[n][k], At[m][k], acc[ai][bj][m][n], 0, 0, 0); } __builtin_amdgcn_s_setprio(0); } while (0)
#define PG8_WAIT_V(n) asm volatile("s_waitcnt vmcnt(" #n ")" ::: "memory")
#define PG8_WAIT_VX(n4, n2) do { if constexpr (HK::EXTRA == 4) PG8_WAIT_V(n4); else if constexpr (HK::EXTRA == 2) PG8_WAIT_V(n2); else PG8_WAIT_V(8); } while (0)
#define PG8_WAIT_L(n) asm volatile("s_waitcnt lgkmcnt(" #n ")" ::: "memory")
#define PG8_BAR __builtin_amdgcn_s_barrier()
#define PG8_SCHED __builtin_amdgcn_sched_barrier(0)
    const int f8_sw = 0x79797979, f8_sx = 0x7f7f7f7f;
    Unit cur, nxt; int ui = 0;
    if (!S.next(0, cur)) return;
    f32x4 acc[2][2][4][2];
#pragma unroll
    for (int a = 0; a < 2; ++a)
#pragma unroll
        for (int b = 0; b < 2; ++b)
#pragma unroll
            for (int m = 0; m < 4; ++m)
#pragma unroll
                for (int n = 0; n < 2; ++n) acc[a][b][m][n] = (f32x4){0.f, 0.f, 0.f, 0.f};
    bf16x8 At[4][2], B0[2][2], B1[2][2];
    const char* cA = (const char*)g.A + (size_t)cur.pm * tstep; const char* cB = (const char*)g.Bt + (size_t)cur.pn * tstep;
    S.a_ready(cur);
    if constexpr (SP2) {
        PG8_STAGE(PG8_SB(0, 0), cB, voffB); PG8_STAGE(PG8_SB(0, 1), cB + hstepB, voffB); PG8_STAGE(PG8_SA(0, 0), cA, voffA); PG8_STAGE(PG8_SA(0, 1), cA + hstepA, voffA);
        if (wr == 1) PG8_BAR;
        PG8_WAIT_V(2); PG8_BAR;
        PG8_STAGE(PG8_SB(1, 0), cB + kstepB, voffB); PG8_STAGE(PG8_SA(1, 0), cA + kstepA, voffA); PG8_STAGE(PG8_SB(1, 1), cB + hstepB + kstepB, voffB);
        PG8_WAIT_V(6); PG8_BAR;
    } else {
        PG8_STAGE(PG8_SB(0, 0), cB, voffB); PG8_STAGE(PG8_SA(0, 0), cA, voffA); PG8_STAGE(PG8_SB(0, 1), cB + hstepB, voffB); PG8_STAGE(PG8_SA(0, 1), cA + hstepA, voffA);
        if (wr == 1) PG8_BAR;
        PG8_WAIT_V(4); PG8_BAR;
        PG8_STAGE(PG8_SB(1, 0), cB + kstepB, voffB); PG8_STAGE(PG8_SA(1, 0), cA + kstepA, voffA); PG8_STAGE(PG8_SB(1, 1), cB + hstepB + kstepB, voffB);
        PG8_WAIT_V(6); PG8_BAR;
    }
    hk.prime();
    for (;;) {
        const bool has_next = S.next(ui + 1, nxt);
        const char* nA = has_next ? (const char*)g.A + (size_t)nxt.pm * tstep : cA; const char* nB = has_next ? (const char*)g.Bt + (size_t)nxt.pn * tstep : cB;
        for (int t = 0; t < nt; t += 2) {
            const bool last = (t == nt - 2);
            const char* a1 = cA + (size_t)(t + 1) * kstepA;
            const char* a2 = last ? nA : cA + (size_t)(t + 2) * kstepA; const char* b2 = last ? nB : cB + (size_t)(t + 2) * kstepB;
            const char* a3 = a2 + kstepA; const char* b3 = b2 + kstepB;
            if (last && has_next) S.a_ready(nxt);
            if constexpr (SP2) {
            PG8_LDB(B0, 0, 0); PG8_LDB(B1, 0, 1); PG8_SCHED; PG8_LDA(At, 0, 0); PG8_STAGE(PG8_SA(1, 1), a1 + hstepA, voffA);
            PG8_WAIT_VX(10, 9); PG8_WAIT_L(0); PG8_BAR; PG8_MMA(0, 0, At, B0); hk.ld(); PG8_MMA(0, 1, At, B1); PG8_BAR; PG8_SCHED;
            PG8_LDA(At, 0, 1); PG8_STAGE(PG8_SB(0, 0), b2, voffB); PG8_STAGE(PG8_SB(0, 1), b2 + hstepB, voffB); PG8_STAGE(PG8_SA(0, 0), a2, voffA);
            PG8_WAIT_VX(12, 10); PG8_WAIT_L(0); PG8_BAR; PG8_MMA(1, 0, At, B0); PG8_MMA(1, 1, At, B1); PG8_BAR; PG8_SCHED;
            PG8_LDB(B0, 1, 0); PG8_LDB(B1, 1, 1); PG8_SCHED; PG8_LDA(At, 1, 0); PG8_STAGE(PG8_SA(0, 1), a2 + hstepA, voffA);
            PG8_WAIT_VX(10, 9); PG8_WAIT_L(0); PG8_BAR; PG8_MMA(0, 0, At, B0); PG8_MMA(0, 1, At, B1); PG8_BAR; PG8_SCHED;
            PG8_LDA(At, 1, 1); PG8_STAGE(PG8_SB(1, 0), b3, voffB); PG8_STAGE(PG8_SB(1, 1), b3 + hstepB, voffB); PG8_STAGE(PG8_SA(1, 0), a3, voffA);
            PG8_WAIT_V(8); PG8_WAIT_L(0); PG8_BAR; hk.rd(); PG8_MMA(1, 0, At, B0); hk.wr(); PG8_MMA(1, 1, At, B1); PG8_BAR; PG8_SCHED;
            } else {
            PG8_LDB(B0, 0, 0); PG8_SCHED; PG8_LDA(At, 0, 0); PG8_STAGE(PG8_SA(1, 1), a1 + hstepA, voffA);
            PG8_WAIT_L(8); PG8_BAR; PG8_WAIT_L(0); PG8_MMA(0, 0, At, B0); PG8_BAR; PG8_SCHED;
            PG8_LDB(B1, 0, 1); PG8_STAGE(PG8_SB(0, 0), b2, voffB);
            PG8_BAR; PG8_WAIT_L(0); PG8_MMA(0, 1, At, B1); PG8_BAR;
            PG8_LDA(At, 0, 1); PG8_STAGE(PG8_SA(0, 0), a2, voffA);
            PG8_BAR; PG8_WAIT_L(0); PG8_MMA(1, 0, At, B0); PG8_BAR; PG8_SCHED;
            PG8_STAGE(PG8_SB(0, 1), b2 + hstepB, voffB);
            PG8_WAIT_V(6); PG8_BAR; PG8_MMA(1, 1, At, B1); PG8_BAR;
            PG8_LDB(B0, 1, 0); PG8_SCHED; PG8_LDA(At, 1, 0); PG8_STAGE(PG8_SA(0, 1), a2 + hstepA, voffA);
            PG8_WAIT_L(8); PG8_BAR; PG8_WAIT_L(0); PG8_MMA(0, 0, At, B0); PG8_BAR; PG8_SCHED;
            PG8_LDB(B1, 1, 1); PG8_STAGE(PG8_SB(1, 0), b3, voffB);
            PG8_BAR; PG8_WAIT_L(0); PG8_MMA(0, 1, At, B1); PG8_BAR;
            PG8_LDA(At, 1, 1); PG8_STAGE(PG8_SA(1, 0), a3, voffA);
            PG8_BAR; PG8_WAIT_L(0); PG8_MMA(1, 0, At, B0); PG8_BAR; PG8_SCHED;
            PG8_STAGE(PG8_SB(1, 1), b3 + hstepB, voffB);
            PG8_WAIT_V(6); PG8_BAR; PG8_MMA(1, 1, At, B1); PG8_BAR;
            }
        }
        if constexpr (QM == 1) asm volatile("s_nop 15\n\ts_nop 15" ::: "memory");
        if constexpr (ALIGN_EPI) { if (wr == 0) PG8_BAR; }
        if constexpr (!Epi::AFTER_DRAIN) { E(acc, cur, wr, wc, fr, fq); S.done(cur); }
        if (!has_next) break;
#pragma unroll
        for (int a = 0; a < 2; ++a)
#pragma unroll
            for (int b = 0; b < 2; ++b)
#pragma unroll
                for (int m = 0; m < 4; ++m)
#pragma unroll
                    for (int n = 0; n < 2; ++n) acc[a][b][m][n] = (f32x4){0.f, 0.f, 0.f, 0.f};
        cur = nxt; cA = nA; cB = nB; ++ui;
        if constexpr (ALIGN_EPI) { if (wr == 1) PG8_BAR; }
    }
    hk.flush();
    PG8_WAIT_V(0);
    if constexpr (!ALIGN_EPI) { if (wr == 0) PG8_BAR; }
    PG8_BAR;
    if constexpr (Epi::AFTER_DRAIN) { E.fused(acc, cur, wr, wc, fr, fq, lds, wid, lane); S.done(cur); }
#undef PG8_SA
#undef PG8_SB
#undef PG8_STAGE
#undef PG8_LDA
#undef PG8_LDB
#undef PG8_MMA
#undef PG8_CAT8
#undef PG8_WAIT_V
#undef PG8_WAIT_VX
#undef PG8_WAIT_L
#undef PG8_BAR
#undef PG8_SCHED
}
}
#define LAS __attribute__((address_space(3)))
typedef unsigned short bf16;
typedef float f32x4 __attribute__((ext_vector_type(4)));
typedef float f32x16 __attribute__((ext_vector_type(16)));
typedef short bf16x8 __attribute__((ext_vector_type(8)));
typedef short s16x4 __attribute__((ext_vector_type(4)));
typedef unsigned u32x4 __attribute__((ext_vector_type(4)));
typedef unsigned u32x2 __attribute__((ext_vector_type(2)));
typedef float f32x2 __attribute__((ext_vector_type(2)));

constexpr int NWAVES = 8, NTHREADS = NWAVES * 64;
constexpr int MP = pg8::MP, MS = pg8::MS, M = pg8::MTOT;
constexpr int DM = 1024, DFF = 2816, NFF2 = 2 * DFF, NIN = 2560, DA = 512, DB = 512, NH = 8;
constexpr int SEQ = 8192, NBATCH = 8, DECB = 128, DECS = 4, WBUF = 2048;
constexpr float LN_EPS = 1e-5f;
constexpr size_t OUT_Y = 0;
constexpr size_t OUT_CKP = (size_t)M * DM;
constexpr size_t OUT_CVP = OUT_CKP + (size_t)NBATCH * WBUF * 512;
constexpr size_t OUT_CKS = OUT_CVP + (size_t)NBATCH * WBUF * 512;
constexpr size_t OUT_CVS = OUT_CKS + (size_t)DECB * WBUF * 512;
constexpr size_t OUT_SGV = OUT_CVS + (size_t)DECB * WBUF * 512;
constexpr size_t OUT_TOTAL = OUT_SGV + (size_t)DECB * DECS * 512;
constexpr size_t MiB = 1u << 20;
constexpr size_t WS_CTL = 0, CTL_ZERO_BYTES = 1 * MiB;
constexpr size_t WS_VEC = 1 * MiB;
constexpr size_t WS_SGUW = 1 * MiB + 256 * 1024;
constexpr size_t WS_VECP = 1 * MiB + 512 * 1024;
constexpr size_t WS_W1IN = 2 * MiB, WS_W1OUT = 13 * MiB, WS_WIN = 19 * MiB, WS_WOUT = 24 * MiB, WS_W2IN = 26 * MiB, WS_W2OUT = 37 * MiB;
constexpr size_t WS_ST1 = 43 * MiB, WS_ST2 = 52 * MiB;
constexpr size_t WS_LSE = 61 * MiB;
constexpr size_t WS_XB = 68 * MiB;
constexpr size_t WS_ZB = 197 * MiB;
constexpr size_t WS_Z = 326 * MiB;
constexpr size_t WS_QKV = 584 * MiB;
constexpr size_t WS_H = 907 * MiB;
constexpr size_t WS_XF8 = 1262 * MiB;
constexpr size_t WS_W1F8 = 1327 * MiB;
constexpr size_t WS_H8 = 1333 * MiB;
constexpr size_t WS_W1O8 = 1511 * MiB, WS_W2O8 = 1514 * MiB;
constexpr size_t WS_XS = 1517 * MiB;
constexpr size_t WS_END = 1518 * MiB;
static_assert(WS_W1IN + (size_t)NFF2 * DM * 2 <= WS_W1OUT && WS_W1OUT + (size_t)DM * DFF * 2 <= WS_WIN && WS_WIN + (size_t)NIN * DM * 2 <= WS_WOUT && WS_WOUT + (size_t)DM * DM * 2 <= WS_W2IN, "ws map 1");
static_assert(WS_W2IN + (size_t)NFF2 * DM * 2 <= WS_W2OUT && WS_W2OUT + (size_t)DM * DFF * 2 <= WS_ST1 && WS_ST1 + (size_t)M * 128 <= WS_ST2 && WS_ST2 + (size_t)M * 128 <= WS_LSE && WS_LSE + (size_t)3 * M * 32 <= WS_XB, "ws map 2");
static_assert(WS_XB + (size_t)M * DM * 2 <= WS_ZB && WS_ZB + (size_t)M * DM * 2 <= WS_Z && WS_Z + (size_t)M * DM * 4 <= WS_QKV && WS_QKV + (size_t)5 * M * 512 * 2 <= WS_H && WS_H + (size_t)M * DFF * 2 <= WS_XF8 && WS_XF8 + (size_t)M * DM <= WS_W1F8 && WS_W1F8 + (size_t)NFF2 * DM <= WS_H8 && WS_H8 + (size_t)M * DFF <= WS_W1O8 && WS_W1O8 + (size_t)DM * DFF <= WS_W2O8 && WS_W2O8 + (size_t)DM * DFF <= WS_XS && WS_XS + ((size_t)3 * M + 2 * NFF2) * 4 <= WS_END, "ws map 3");
constexpr int CW_BAR = 4096;
constexpr int RING_BYTES = 131072, MISC_OFF = RING_BYTES, EX_OFF = RING_BYTES + 1024, CPY_OFF = RING_BYTES + 2048, LDS_BYTES = 163840;

#define LDS_WAIT() asm volatile("s_waitcnt lgkmcnt(0)" ::: "memory")
__device__ __forceinline__ unsigned f2bf(float f) { unsigned u = __builtin_bit_cast(unsigned, f); return (u + 0x7fffu + ((u >> 16) & 1u)) >> 16; }
typedef float f32x2_t __attribute__((ext_vector_type(2))); typedef __bf16 bf16x2_t __attribute__((ext_vector_type(2)));
__device__ __forceinline__ unsigned pk2(float lo, float hi) { const f32x2_t v = {lo, hi}; const bf16x2_t b = __builtin_convertvector(v, bf16x2_t); return __builtin_bit_cast(unsigned, b); }
__device__ __forceinline__ unsigned pk4_fp8(float a, float b, float c, float d) { int w = __builtin_amdgcn_cvt_pk_fp8_f32(a, b, 0, false); w = __builtin_amdgcn_cvt_pk_fp8_f32(c, d, w, true); return (unsigned)w; }
__device__ __forceinline__ unsigned pk4_i8(float a, float b, float c, float d) { return ((unsigned)(int)__builtin_rintf(a) & 255u) | (((unsigned)(int)__builtin_rintf(b) & 255u) << 8) | (((unsigned)(int)__builtin_rintf(c) & 255u) << 16) | ((unsigned)(int)__builtin_rintf(d) << 24); }
__device__ __forceinline__ float bflo(unsigned w) { return __uint_as_float(w << 16); }
__device__ __forceinline__ float bfhi(unsigned w) { return __uint_as_float(w & 0xffff0000u); }
__device__ __forceinline__ float wave_sum(float v) {
#pragma unroll
    for (int o = 1; o < 64; o <<= 1) v += __shfl_xor(v, o);
    return v;
}
__device__ __forceinline__ float wave_max(float v) {
#pragma unroll
    for (int o = 1; o < 64; o <<= 1) v = fmaxf(v, __shfl_xor(v, o));
    return v;
}
__device__ __forceinline__ void unpack8(const u32x4 w, float (&v)[8]) { v[0] = bflo(w.x); v[1] = bfhi(w.x); v[2] = bflo(w.y); v[3] = bfhi(w.y); v[4] = bflo(w.z); v[5] = bfhi(w.z); v[6] = bflo(w.w); v[7] = bfhi(w.w); }
#define XB_TMO      128
#define XB_XCNT(j)  (256  + 64 * (j))
#define XB_XSUB(j)  (1280 + 64 * (j))
#define XB_XGEN(j)  (2304 + 64 * (j))
#define XB_TOP      3328
#define XB_TOPGEN   3392
#define XCD_BAR_WORDS 3456
#define XB_SPIN_CAP (1u << 18)

__device__ __forceinline__ unsigned xb_ld(unsigned* p)              { return __hip_atomic_load(p, __ATOMIC_RELAXED, __HIP_MEMORY_SCOPE_AGENT); }
__device__ __forceinline__ unsigned xb_add(unsigned* p, unsigned v) { return __hip_atomic_fetch_add(p, v, __ATOMIC_RELAXED, __HIP_MEMORY_SCOPE_AGENT); }
__device__ __forceinline__ unsigned xb_xcc_id() { return (unsigned)__builtin_amdgcn_s_getreg((3 << 11) | 20) & 0xFu; }
#define XB_SPIN(cond, bar) do { unsigned _sp = 0; while (cond) { __builtin_amdgcn_s_sleep(1); \
    if ((++_sp & 255u) == 0u) { if (xb_ld(&(bar)[XB_TMO])) break; if (_sp > XB_SPIN_CAP) { atomicAdd(&(bar)[XB_TMO], 1u); break; } } } } while (0)

struct XcdBarrier {
    unsigned* bar; unsigned x;
    volatile LAS unsigned* st;
};

__device__ __forceinline__ XcdBarrier xcd_barrier_post(unsigned* bar, volatile LAS unsigned* st) {
    XcdBarrier b; b.bar = bar; b.x = xb_xcc_id(); b.st = st;
    if (threadIdx.x == 0) (void)xb_add(&bar[XB_XCNT(b.x)], 1u);
    return b;
}
__device__ __forceinline__ void xcd_barrier_complete(unsigned* bar, unsigned x, unsigned& nloc, unsigned& nx) {
    const unsigned G = gridDim.x * gridDim.y * gridDim.z;
    unsigned sum, cnt, mine, sp = 0u;
    for (;;) {
        sum = 0u; cnt = 0u; mine = 0u;
#pragma unroll
        for (unsigned j = 0; j < 16; ++j) { const unsigned c = xb_ld(&bar[XB_XCNT(j)]); sum += c; cnt += (c > 0u) ? 1u : 0u; mine = (j == x) ? c : mine; }
        if (sum == G) break;
        __builtin_amdgcn_s_sleep(1);
        if ((++sp & 255u) == 0u) { if (xb_ld(&bar[XB_TMO])) break; if (sp > XB_SPIN_CAP) { atomicAdd(&bar[XB_TMO], 1u); break; } }
    }
    nloc = mine > 0u ? mine : 1u; nx = cnt > 0u ? cnt : 1u;
}

__device__ __forceinline__ void xcd_barrier(const XcdBarrier& b) {
    asm volatile("s_waitcnt vmcnt(0)" ::: "memory");
    __syncthreads();
    if (threadIdx.x == 0) {
        unsigned* bar = b.bar;
        __builtin_amdgcn_s_waitcnt(0);
        unsigned nloc = b.st[0], nx = b.st[1];
        if (nloc == 0u) { xcd_barrier_complete(bar, b.x, nloc, nx); b.st[0] = nloc; b.st[1] = nx; }
        const unsigned old = xb_add(&bar[XB_XSUB(b.x)], 1u);
        const unsigned gen = old / nloc;
        if (old + 1u == (gen + 1u) * nloc) {
            __builtin_amdgcn_fence(__ATOMIC_RELEASE, "agent");
            asm volatile("s_waitcnt vmcnt(0)" ::: "memory");
            const unsigned og = xb_add(&bar[XB_TOP], 1u);
            const unsigned tg = og / nx;
            if (og + 1u == (tg + 1u) * nx) xb_add(&bar[XB_TOPGEN], 1u);
            else XB_SPIN(xb_ld(&bar[XB_TOPGEN]) == tg, bar);
            __builtin_amdgcn_fence(__ATOMIC_ACQUIRE, "agent");
            xb_add(&bar[XB_XGEN(b.x)], 1u);
            asm volatile("s_waitcnt vmcnt(0)" ::: "memory");
        } else {
            XB_SPIN(xb_ld(&bar[XB_XGEN(b.x)]) == gen, bar);
            __builtin_amdgcn_fence(__ATOMIC_ACQUIRE, "agent");
            asm volatile("s_waitcnt vmcnt(0)" ::: "memory");
        }
    }
    __syncthreads();
}
#ifndef P1_F8_HALF
#define P1_F8_HALF 0
#endif
__device__ __forceinline__ void wprep_dma(const float* W, int N, int k0, int n0, LAS float* buf, int lane) {
#pragma unroll
    for (int i = 0; i < 8; ++i)
        __builtin_amdgcn_global_load_lds((const unsigned*)(W + (size_t)(k0 + 8 * i + (lane >> 3)) * N + n0 + 4 * (((lane & 7) - i) & 7)), (LAS unsigned*)(buf + i * 256), 16, 0, 0);
}
__device__ __forceinline__ int wprep_off(int c, int n) { return (8 * c) * 32 + (((((n) >> 2) + c) & 7) << 2) + (n & 3); }
template <bool SCALE, bool SUMS, bool F8 = false>
__device__ __forceinline__ void wprep_item(const float* W, int K, int N, bf16* WT, int n0, int rho0, int kb0, int nkb, const float* gsc, const float* bvec, float* s_out, float* t_out, LAS float* scr, int lane) {
    float sacc[4] = {0.f, 0.f, 0.f, 0.f}, tacc[4] = {0.f, 0.f, 0.f, 0.f};
    const int c = lane & 7;
    for (int kp = kb0; kp < kb0 + nkb; kp += 2) {
        wprep_dma(W, N, kp * 64, n0, scr, lane); wprep_dma(W, N, (kp + 1) * 64, n0, scr + 2048, lane);
        asm volatile("s_waitcnt vmcnt(0)" ::: "memory");
#pragma unroll
        for (int h = 0; h < 2; ++h) {
        const int kb = kp + h, k0 = kb * 64; const LAS float* buf = scr + h * 2048;
        float gk[8], bk[8];
        if (SCALE) { const f32x4 a = *(const f32x4*)(gsc + k0 + 8 * c), b = *(const f32x4*)(gsc + k0 + 8 * c + 4); gk[0] = a[0]; gk[1] = a[1]; gk[2] = a[2]; gk[3] = a[3]; gk[4] = b[0]; gk[5] = b[1]; gk[6] = b[2]; gk[7] = b[3]; }
        if (SUMS) { const f32x4 a = *(const f32x4*)(bvec + k0 + 8 * c), b = *(const f32x4*)(bvec + k0 + 8 * c + 4); bk[0] = a[0]; bk[1] = a[1]; bk[2] = a[2]; bk[3] = a[3]; bk[4] = b[0]; bk[5] = b[1]; bk[6] = b[2]; bk[7] = b[3]; }
#pragma unroll
        for (int j = 0; j < 4; ++j) {
            const int n = (lane >> 3) + 8 * j; const LAS float* s = buf + wprep_off(c, n);
            float v[8];
#pragma unroll
            for (int e = 0; e < 8; ++e) v[e] = s[e * 32];
            if (SUMS) {
#pragma unroll
                for (int e = 0; e < 8; ++e) tacc[j] += bk[e] * v[e];
            }
            if (SCALE) {
#pragma unroll
                for (int e = 0; e < 8; ++e) v[e] *= gk[e];
            }
            u32x4 o; o.x = pk2(v[0], v[1]); o.y = pk2(v[2], v[3]); o.z = pk2(v[4], v[5]); o.w = pk2(v[6], v[7]);
            if (SUMS) sacc[j] += ((bflo(o.x) + bfhi(o.x)) + (bflo(o.y) + bfhi(o.y))) + ((bflo(o.z) + bfhi(o.z)) + (bflo(o.w) + bfhi(o.w)));
            if (F8) { const int rho = rho0 + n, kk = k0 + 8 * c; u32x2 q; q.x = pk4_fp8(v[0] * 64.f, v[1] * 64.f, v[2] * 64.f, v[3] * 64.f); q.y = pk4_fp8(v[4] * 64.f, v[5] * 64.f, v[6] * 64.f, v[7] * 64.f);
                *(u32x2*)((unsigned char*)WT + (size_t)(rho >> 8) * ((size_t)256 * K) + (size_t)(kk >> 7) * (256 * 128) + (size_t)(rho & 255) * 128 + (kk & 127)) = q; }
            else { const int rho = rho0 + n; *(u32x4*)(WT + (size_t)(rho >> 8) * ((size_t)256 * K) + (size_t)kb * (256 * 64) + (size_t)(rho & 255) * 64 + 8 * c) = o; }
        }
        }
        LDS_WAIT(); asm volatile("" ::: "memory");
    }
    if (SUMS) {
#pragma unroll
        for (int j = 0; j < 4; ++j) {
            float s = sacc[j], t = tacc[j];
            s += __shfl_xor(s, 1); s += __shfl_xor(s, 2); s += __shfl_xor(s, 4);
            t += __shfl_xor(t, 1); t += __shfl_xor(t, 2); t += __shfl_xor(t, 4);
            if (c == 0) { const int n = (lane >> 3) + 8 * j; s_out[rho0 + n] = s; t_out[rho0 + n] = t; }
        }
    }
}
constexpr int I8_RED = CPY_OFF;
template <bool FOLDLN>
__device__ __forceinline__ void wprep_i8_wg(const float* W, int N, unsigned char* WT, int n0, int rho0, float* wsc, const float* gsc, const float* bvec, float* vecp, int vstride, LAS unsigned char* lds, int tid) {
    const int lane = tid & 63, wave = tid >> 6, c = lane & 7, nl = lane >> 3;
    LAS float* scr = (LAS float*)(lds + wave * 16384);
    LAS float* red = (LAS float*)(lds + I8_RED);
    static_assert(8 * 16384 <= MISC_OFF && I8_RED + 3 * 1024 <= LDS_BYTES, "int8 weight staging must not touch the barrier words");
    wprep_dma(W, N, (2 * wave) * 64, n0, scr, lane); wprep_dma(W, N, (2 * wave + 1) * 64, n0, scr + 2048, lane);
    asm volatile("s_waitcnt vmcnt(0)" ::: "memory");
    float gk[2][8], bk[2][8];
    if (FOLDLN) {
#pragma unroll
        for (int h = 0; h < 2; ++h) { const int kq = (2 * wave + h) * 64 + 8 * c;
            const f32x4 a = *(const f32x4*)(gsc + kq), b = *(const f32x4*)(gsc + kq + 4), a2 = *(const f32x4*)(bvec + kq), b2 = *(const f32x4*)(bvec + kq + 4);
            gk[h][0] = a[0]; gk[h][1] = a[1]; gk[h][2] = a[2]; gk[h][3] = a[3]; gk[h][4] = b[0]; gk[h][5] = b[1]; gk[h][6] = b[2]; gk[h][7] = b[3];
            bk[h][0] = a2[0]; bk[h][1] = a2[1]; bk[h][2] = a2[2]; bk[h][3] = a2[3]; bk[h][4] = b2[0]; bk[h][5] = b2[1]; bk[h][6] = b2[2]; bk[h][7] = b2[3]; }
    }
    float cmax[4] = {0.f, 0.f, 0.f, 0.f}, inv[4], qsum[4] = {0.f, 0.f, 0.f, 0.f}, tacc[4] = {0.f, 0.f, 0.f, 0.f};
#pragma unroll
    for (int h = 0; h < 2; ++h)
#pragma unroll
        for (int j = 0; j < 4; ++j) { const LAS float* s = scr + h * 2048 + wprep_off(c, nl + 8 * j);
#pragma unroll
            for (int e = 0; e < 8; ++e) { float v = s[e * 32]; if (FOLDLN) v *= gk[h][e]; cmax[j] = fmaxf(cmax[j], fabsf(v)); } }
#pragma unroll
    for (int j = 0; j < 4; ++j) { float m = cmax[j]; m = fmaxf(m, __shfl_xor(m, 1)); m = fmaxf(m, __shfl_xor(m, 2)); m = fmaxf(m, __shfl_xor(m, 4)); if (c == 0) red[wave * 32 + nl + 8 * j] = m; }
    __syncthreads();
#pragma unroll
    for (int j = 0; j < 4; ++j) { float m = 0.f;
#pragma unroll
        for (int w = 0; w < 8; ++w) m = fmaxf(m, red[w * 32 + nl + 8 * j]);
        inv[j] = m > 0.f ? 127.0f / m : 0.f; cmax[j] = m * (1.0f / 127.0f);
        if (wave == 0 && c == 0) wsc[rho0 + nl + 8 * j] = cmax[j]; }
#pragma unroll
    for (int h = 0; h < 2; ++h)
#pragma unroll
        for (int j = 0; j < 4; ++j) { const LAS float* s = scr + h * 2048 + wprep_off(c, nl + 8 * j);
            float v[8];
#pragma unroll
            for (int e = 0; e < 8; ++e) { v[e] = s[e * 32]; if (FOLDLN) { tacc[j] += bk[h][e] * v[e]; v[e] *= gk[h][e]; } v[e] = __builtin_rintf(v[e] * inv[j]); qsum[j] += v[e]; }
            u32x2 q; q.x = pk4_i8(v[0], v[1], v[2], v[3]); q.y = pk4_i8(v[4], v[5], v[6], v[7]);
            const int rho = rho0 + nl + 8 * j, kk = (2 * wave + h) * 64 + 8 * c;
            *(u32x2*)(WT + (size_t)(rho >> 8) * ((size_t)256 * 1024) + (size_t)(kk >> 7) * (256 * 128) + (size_t)(rho & 255) * 128 + (kk & 127)) = q; }
    if (FOLDLN) {
#pragma unroll
        for (int j = 0; j < 4; ++j) { float s = qsum[j], t = tacc[j];
            s += __shfl_xor(s, 1); s += __shfl_xor(s, 2); s += __shfl_xor(s, 4);
            t += __shfl_xor(t, 1); t += __shfl_xor(t, 2); t += __shfl_xor(t, 4);
            if (c == 0) { red[256 + wave * 32 + nl + 8 * j] = s; red[512 + wave * 32 + nl + 8 * j] = t; } }
        __syncthreads();
        if (tid < 32) { float s = 0.f, t = 0.f;
#pragma unroll
            for (int w = 0; w < 8; ++w) { s += red[256 + w * 32 + tid]; t += red[512 + w * 32 + tid]; }
            float m = 0.f;
#pragma unroll
            for (int w = 0; w < 8; ++w) m = fmaxf(m, red[w * 32 + tid]);
            const int rho = rho0 + tid; vecp[rho] = s * (m * (1.0f / 127.0f)); vecp[NFF2 + rho] = t;
#pragma unroll
            for (int q = 1; q < 4; ++q) { vecp[q * vstride + rho] = 0.f; vecp[q * vstride + NFF2 + rho] = 0.f; } }
    }
    __syncthreads();
}
__device__ __forceinline__ int ffn_rho(int n) { return (n < DFF) ? ((n >> 7) * 256 + (n & 127)) : (((n - DFF) >> 7) * 256 + 128 + ((n - DFF) & 127)); }

constexpr int VEC_FLOATS = 2 * NIN + 2 * NFF2;
__device__ __forceinline__ void vec_reduce(const float* VECP, float* VEC, int gt, int NGT) { for (int i = gt; i < VEC_FLOATS; i += NGT) VEC[i] = (VECP[i] + VECP[VEC_FLOATS + i]) + (VECP[2 * VEC_FLOATS + i] + VECP[3 * VEC_FLOATS + i]); }
struct P0Args {
    const float *xp, *xs, *ck, *cv, *w1in, *w1out, *ln1g, *ln1b, *win, *sguw, *oag, *obg, *wout, *ln2g, *ln2b, *w2in, *w2out;
    bf16 *W1F8, *W1O8, *W2O8, *W2I8, *W1IN, *W1OUT, *WIN, *WOUT, *W2IN, *W2OUT, *SGUW, *XB; unsigned char* XF8; float* XS; float* VECP; float* out;
};
__device__ __forceinline__ void p0_prologue(const P0Args& a, LAS unsigned char* lds, int vcu, int G, int tid) {
    const int lane = tid & 63, wave = tid >> 6;
    LAS float* scr = (LAS float*)(lds + wave * 16384);
    const int gw = vcu * NWAVES + wave, NGW = G * NWAVES;
    for (int it = vcu; it < 352; it += G) {
        if (it < 176) { const int n0 = it * 32; wprep_i8_wg<false>(a.w1in, NFF2, (unsigned char*)a.W1F8, n0, ffn_rho(n0), a.XS + M, nullptr, nullptr, nullptr, 0, lds, tid); }
        else { const int n0 = (it - 176) * 32; wprep_i8_wg<true>(a.w2in, NFF2, (unsigned char*)a.W2I8, n0, ffn_rho(n0), a.XS + M + NFF2, a.ln2g, a.ln2b, a.VECP + 2 * NIN, VEC_FLOATS, lds, tid); }
    }
    constexpr int J0 = 80 * 4, J1 = J0 + 32 * 11, J2 = J1 + 32 * 4, J3 = J2 + 32 * 11, J4 = J3 + 32 * 11, J5 = J4 + 32 * 11;
    for (int it = gw; it < J5; it += NGW) {
        if (it < J0) { const int r = it, n0 = (r >> 2) * 32, q = r & 3; float* pv = a.VECP + q * VEC_FLOATS; wprep_item<true, true>(a.win, DM, NIN, a.WIN, n0, n0, q * 4, 4, a.ln1g, a.ln1b, pv, pv + NIN, scr, lane); }
        else if (it < J1) { const int r = it - J0, n0 = (r / 11) * 32; wprep_item<false, false>(a.w1out, DFF, DM, a.W1OUT, n0, n0, (r % 11) * 4, 4, nullptr, nullptr, nullptr, nullptr, scr, lane); }
        else if (it < J2) { const int r = it - J1, n0 = (r >> 2) * 32, kb0 = (r & 3) * 4;
            wprep_item<true, false>(a.wout, DM, DM, a.WOUT, n0, n0, kb0, 4, (kb0 < 8) ? a.oag : (a.obg - 512), nullptr, nullptr, nullptr, scr, lane); }
        else if (it < J3) { const int r = it - J2, n0 = (r / 11) * 32; wprep_item<false, false>(a.w2out, DFF, DM, a.W2OUT, n0, n0, (r % 11) * 4, 4, nullptr, nullptr, nullptr, nullptr, scr, lane); }
        else if (it < J4) { const int r = it - J3, n0 = (r / 11) * 32; wprep_item<false, false, true>(a.w1out, DFF, DM, a.W1O8, n0, n0, (r % 11) * 4, 4, nullptr, nullptr, nullptr, nullptr, scr, lane); }
        else { const int r = it - J4, n0 = (r / 11) * 32; wprep_item<false, false, true>(a.w2out, DFF, DM, a.W2O8, n0, n0, (r % 11) * 4, 4, nullptr, nullptr, nullptr, nullptr, scr, lane); }
    }
    const int gt = vcu * NTHREADS + tid, NGT = G * NTHREADS;
    for (int i = gt; i < 4 * 128 * 128; i += NGT) { const int r = (i >> 7) & 127, cidx = i & 127; a.SGUW[i] = (bf16)f2bf((cidx <= r) ? a.sguw[i] : 0.f); }
    for (size_t row = gw; row < (size_t)M; row += 4 * (size_t)NGW) {
        f32x4 v[4][4];
#pragma unroll
        for (int q = 0; q < 4; ++q) { const size_t rq = row + (size_t)q * NGW; if (rq < (size_t)M) { const float* src = (rq < (size_t)MP) ? a.xp + rq * DM : a.xs + (rq - MP) * DM;
#pragma unroll
            for (int j = 0; j < 4; ++j) v[q][j] = __builtin_nontemporal_load((const f32x4*)(src + 4 * lane + 256 * j)); } }
#pragma unroll
        for (int q = 0; q < 4; ++q) { const size_t rq = row + (size_t)q * NGW; if (rq < (size_t)M) {
            float am = 0.f;
#pragma unroll
            for (int j = 0; j < 4; ++j) am = fmaxf(fmaxf(am, fmaxf(fabsf(v[q][j][0]), fabsf(v[q][j][1]))), fmaxf(fabsf(v[q][j][2]), fabsf(v[q][j][3])));
            am = wave_max(am);
            const float inv = am > 0.f ? 127.0f / am : 0.f;
            if (lane == 0) a.XS[rq] = am * (1.0f / 127.0f);
            unsigned char* xi = a.XF8 + (rq >> 8) * ((size_t)256 * DM) + (rq & 255) * 128;
#pragma unroll
            for (int j = 0; j < 4; ++j) {
                u32x2 o; o.x = pk2(v[q][j][0], v[q][j][1]); o.y = pk2(v[q][j][2], v[q][j][3]);
                if (rq >= (size_t)MP) *(u32x2*)(a.XB + rq * DM + 4 * lane + 256 * j) = o;
                const int c = 4 * lane + 256 * j;
                *(unsigned*)(xi + (size_t)(c >> 7) * (256 * 128) + (c & 127)) = pk4_i8(v[q][j][0] * inv, v[q][j][1] * inv, v[q][j][2] * inv, v[q][j][3] * inv);
            } } }
    }
}
__device__ __forceinline__ s16x4 tr_read(LAS unsigned char* p) {
    typedef short v4i16_t __attribute__((ext_vector_type(4)));
    return __builtin_bit_cast(s16x4, __builtin_amdgcn_ds_read_tr16_b64_v4i16((LAS v4i16_t*)p));
}
constexpr int ATT_K_OFF = 0, ATT_V_OFF = 49152, ATT_O_OFF = 98304;
struct AttnKV { u32x4 kv[6], vv[6]; bf16x8 qf[4]; };
__device__ __forceinline__ void attn_issue(AttnKV& R, const bf16* QB, const bf16* KB, const bf16* VB, int b, int dil, int r, int blk, int h, int tid) {
    const int s0 = blk * 256 - 128; const size_t rowb = (size_t)b * SEQ;
#pragma unroll
    for (int i = 0; i < 6; ++i) {
        const int c = tid + NTHREADS * i, row = c >> 3, ch = c & 7, s = s0 + row;
        R.kv[i] = (u32x4){0u, 0u, 0u, 0u}; R.vv[i] = (u32x4){0u, 0u, 0u, 0u};
        if (s >= 0) { const size_t off = (rowb + (size_t)r + (size_t)dil * s) * 512 + h * 64 + ch * 8; R.kv[i] = *(const u32x4*)(KB + off); R.vv[i] = *(const u32x4*)(VB + off); }
    }    const int lane = tid & 63, wid = tid >> 6, q = lane & 31, hh = lane >> 5;
    const size_t qrow = rowb + (size_t)r + (size_t)dil * (blk * 256 + 32 * wid + q);
#pragma unroll
    for (int d0 = 0; d0 < 4; ++d0) R.qf[d0] = *(const bf16x8*)(QB + qrow * 512 + h * 64 + 16 * d0 + 8 * hh);
}
__device__ __forceinline__ void attn_fill(LAS unsigned char* lds, const AttnKV& R, int tid) {
#pragma unroll
    for (int i = 0; i < 6; ++i) {
        const int c = tid + NTHREADS * i, row = c >> 3, ch = c & 7;
        *(LAS u32x4*)(lds + ATT_K_OFF + row * 128 + ((ch ^ ((row >> 1) & 7)) << 4)) = R.kv[i];
        *(LAS u32x4*)(lds + ATT_V_OFF + row * 128 + ((ch ^ (((row >> 1) & 1) << 2)) << 4)) = R.vv[i];
    }
}
__device__ __forceinline__ float lane32_max(float v) { const auto rr = __builtin_amdgcn_permlane32_swap(__float_as_uint(v), __float_as_uint(v), false, false); return fmaxf(__uint_as_float(rr[0]), __uint_as_float(rr[1])); }
__device__ __forceinline__ float lane32_sum(float v) { const auto rr = __builtin_amdgcn_permlane32_swap(__float_as_uint(v), __float_as_uint(v), false, false); return __uint_as_float(rr[0]) + __uint_as_float(rr[1]); }
__device__ __forceinline__ f32x16 att_qk(LAS unsigned char* lds, int rho0, const bf16x8 (&qf)[4], int q, int hh) {
    f32x16 sa;
#pragma unroll
    for (int i = 0; i < 16; ++i) sa[i] = 0.f;
#pragma unroll
    for (int d0 = 0; d0 < 4; ++d0) { const bf16x8 kf = *(const LAS bf16x8*)(lds + ATT_K_OFF + (rho0 + q) * 128 + (((2 * d0 + hh) ^ ((q >> 1) & 7)) << 4)); sa = __builtin_amdgcn_mfma_f32_32x32x16_bf16(kf, qf[d0], sa, 0, 0, 0); }
    return sa;
}
template <int TT> __device__ __forceinline__ void att_mask(f32x16& s, bool exists, int q, int hh) {
#pragma unroll
    for (int i = 0; i < 16; ++i) { const int kk = (i & 3) + 8 * (i >> 2) + 4 * hh; const bool off = !exists || (TT == 0 && kk < q) || (TT == 4 && kk > q); if (off) s[i] = -1e30f; }
}
__device__ __forceinline__ void att_pv(LAS unsigned char* lds, int rho0, const f32x16& p, f32x16& o0, f32x16& o1, int lane, int hh) {
    bf16x8 pf[2];
#pragma unroll
    for (int s = 0; s < 2; ++s) { u32x4 w; w.x = pk2(p[8 * s + 0], p[8 * s + 1]); w.y = pk2(p[8 * s + 2], p[8 * s + 3]); w.z = pk2(p[8 * s + 4], p[8 * s + 5]); w.w = pk2(p[8 * s + 6], p[8 * s + 7]); pf[s] = __builtin_bit_cast(bf16x8, w); }
#pragma unroll
    for (int s = 0; s < 2; ++s)
#pragma unroll
        for (int d0 = 0; d0 < 2; ++d0) {
            const int qq = (lane & 15) >> 2, rowA = rho0 + 16 * s + 4 * hh + qq;
            const int chv = (4 * d0 + 2 * ((lane >> 4) & 1) + ((lane & 3) >> 1)) ^ ((qq >> 1) << 2);
            LAS unsigned char* addrA = lds + ATT_V_OFF + rowA * 128 + (chv << 4) + 8 * (lane & 1);
            const s16x4 va = tr_read(addrA), vb = tr_read(addrA + 8 * 128);
            const bf16x8 vf = (bf16x8){va[0], va[1], va[2], va[3], vb[0], vb[1], vb[2], vb[3]};
            if (d0 == 0) o0 = __builtin_amdgcn_mfma_f32_32x32x16_bf16(vf, pf[s], o0, 0, 0, 0); else o1 = __builtin_amdgcn_mfma_f32_32x32x16_bf16(vf, pf[s], o1, 0, 0, 0);
        }
}
template <int TA, int TB> __device__ __forceinline__ void att_round(LAS unsigned char* lds, const bf16x8 (&qf)[4], f32x16& o0, f32x16& o1, float& m, float& l, int s0, int wid, int lane, int q, int hh) {
    const int rho0a = 32 * wid + 32 * TA, rho0b = 32 * wid + 32 * (TB < 0 ? TA : TB);
    const bool ea = s0 + rho0a >= 0, eb = (TB >= 0) && (s0 + rho0b >= 0);
    if (!(ea || eb)) return;
    f32x16 sa = att_qk(lds, rho0a, qf, q, hh), sb;
    if (TB >= 0) sb = att_qk(lds, rho0b, qf, q, hh);
    att_mask<TA>(sa, ea, q, hh);
    if (TB >= 0) att_mask<TB>(sb, eb, q, hh);
    float mx = sa[0];
#pragma unroll
    for (int i = 1; i < 16; ++i) mx = fmaxf(mx, sa[i]);
    if (TB >= 0) {
#pragma unroll
        for (int i = 0; i < 16; ++i) mx = fmaxf(mx, sb[i]);
    }
    mx = lane32_max(mx);
    const float mn = fmaxf(m, mx), alpha = __builtin_amdgcn_exp2f(m - mn);
    m = mn;
    float ps = 0.f;
#pragma unroll
    for (int i = 0; i < 16; ++i) { sa[i] = __builtin_amdgcn_exp2f(sa[i] - mn); ps += sa[i]; }
    if (TB >= 0) {
#pragma unroll
        for (int i = 0; i < 16; ++i) { sb[i] = __builtin_amdgcn_exp2f(sb[i] - mn); ps += sb[i]; }
    }
    l = l * alpha + lane32_sum(ps);
#pragma unroll
    for (int i = 0; i < 16; ++i) { o0[i] *= alpha; o1[i] *= alpha; }
    att_pv(lds, rho0a, sa, o0, o1, lane, hh);
    if (TB >= 0) att_pv(lds, rho0b, sb, o0, o1, lane, hh);
}
__device__ __forceinline__ void attn_compute(LAS unsigned char* lds, const bf16x8 (&qf)[4], bf16* OPg, float* LSEg, int b, int dil, int r, int blk, int h, int tid) {
    const int lane = tid & 63, wid = tid >> 6;
    const int s0 = blk * 256 - 128;
    const size_t rowb = (size_t)b * SEQ;
    const int q = lane & 31, hh = lane >> 5;
    const int sq = blk * 256 + 32 * wid + q;
    const size_t qrow = rowb + (size_t)r + (size_t)dil * sq;
    f32x16 o0, o1;
#pragma unroll
    for (int i = 0; i < 16; ++i) { o0[i] = 0.f; o1[i] = 0.f; }
    float m = -1e30f, l = 0.f;
    att_round<0, 1>(lds, qf, o0, o1, m, l, s0, wid, lane, q, hh);
    att_round<2, 3>(lds, qf, o0, o1, m, l, s0, wid, lane, q, hh);
    att_round<4, -1>(lds, qf, o0, o1, m, l, s0, wid, lane, q, hh);
    const float inv = 1.0f / l;
    LAS unsigned char* stg = lds + ATT_O_OFF + wid * 4096;
#pragma unroll
    for (int g4 = 0; g4 < 4; ++g4) {
        u32x2 w0, w1;
        w0.x = pk2(o0[4 * g4 + 0] * inv, o0[4 * g4 + 1] * inv); w0.y = pk2(o0[4 * g4 + 2] * inv, o0[4 * g4 + 3] * inv);
        w1.x = pk2(o1[4 * g4 + 0] * inv, o1[4 * g4 + 1] * inv); w1.y = pk2(o1[4 * g4 + 2] * inv, o1[4 * g4 + 3] * inv);
        *(LAS u32x2*)(stg + q * 128 + ((g4 ^ ((q >> 1) & 7)) << 4) + 8 * hh) = w0;
        *(LAS u32x2*)(stg + q * 128 + (((4 + g4) ^ ((q >> 1) & 7)) << 4) + 8 * hh) = w1;
    }
    LDS_WAIT();
    {
        const size_t rbase = rowb + (size_t)r + (size_t)dil * (blk * 256 + 32 * wid);
#pragma unroll
        for (int i4 = 0; i4 < 4; ++i4) {
            const int rl = 8 * i4 + (lane >> 3), ch = lane & 7;
            const u32x4 v = *(const LAS u32x4*)(stg + rl * 128 + ((ch ^ ((rl >> 1) & 7)) << 4));
            __builtin_nontemporal_store(v, (u32x4*)(OPg + (rbase + (size_t)dil * rl) * 512 + h * 64 + ch * 8));
        }
    }
    if (hh == 0) LSEg[qrow * 8 + h] = m + log2f(l);
    __syncthreads();
}

__device__ __forceinline__ void dec_update(float sc, const float (&v)[8], float& m, float& l, float (&o)[8]) {
    const float mn = fmaxf(m, sc), alpha = __builtin_amdgcn_exp2f(m - mn), p = __builtin_amdgcn_exp2f(sc - mn);
    m = mn; l = l * alpha + p;
#pragma unroll
    for (int e = 0; e < 8; ++e) o[e] = o[e] * alpha + p * v[e];
}
__device__ __forceinline__ void decode_task(const bf16* QB, const bf16* KB, const bf16* VB, const float* ck, const float* cv, bf16* OP0, int b, int h, int t, int lane) {
    const int kq = lane >> 3, dp = lane & 7;
    const size_t row = (size_t)MP + 4 * b + t;
    float qv[8]; unpack8(*(const u32x4*)(QB + row * 512 + h * 64 + 8 * dp), qv);
    const float* ckb = ck + (size_t)b * WBUF * 512 + h * 64 + 8 * dp; const float* cvb = cv + (size_t)b * WBUF * 512 + h * 64 + 8 * dp;
    float m = -1e30f, l = 0.f, o[8];
#pragma unroll
    for (int e = 0; e < 8; ++e) o[e] = 0.f;
    for (int r0 = 0; r0 < 49; r0 += 7) {
        f32x4 k0[7], k1[7], v0[7], v1[7]; bool ok[7];
#pragma unroll
        for (int u = 0; u < 7; ++u) {
            const int s = (r0 + u) * 8 + kq, g = s / 129, j = s - 129 * g, idx = WBUF + t - (j << (2 * g));
            ok[u] = s < 387 && idx < WBUF;
            const size_t ro = (size_t)(ok[u] ? idx : 0) * 512;
            k0[u] = *(const f32x4*)(ckb + ro); k1[u] = *(const f32x4*)(ckb + ro + 4); v0[u] = *(const f32x4*)(cvb + ro); v1[u] = *(const f32x4*)(cvb + ro + 4);
        }
#pragma unroll
        for (int u = 0; u < 7; ++u) {
            float sc = ((qv[0] * k0[u][0] + qv[1] * k0[u][1]) + (qv[2] * k0[u][2] + qv[3] * k0[u][3])) + ((qv[4] * k1[u][0] + qv[5] * k1[u][1]) + (qv[6] * k1[u][2] + qv[7] * k1[u][3]));
            sc += __shfl_xor(sc, 1); sc += __shfl_xor(sc, 2); sc += __shfl_xor(sc, 4);
            sc = ok[u] ? sc : -1e30f;
            const float vv[8] = {v0[u][0], v0[u][1], v0[u][2], v0[u][3], v1[u][0], v1[u][1], v1[u][2], v1[u][3]};
            dec_update(sc, vv, m, l, o);
        }
    }
    {
        const bool nok = (kq < 4) ? (kq <= t) : (kq < 6); const int nr = (kq < 4 && kq <= t) ? (t - kq) : t;
        float kv8[8], vv[8];
        unpack8(*(const u32x4*)(KB + ((size_t)MP + 4 * b + nr) * 512 + h * 64 + 8 * dp), kv8); unpack8(*(const u32x4*)(VB + ((size_t)MP + 4 * b + nr) * 512 + h * 64 + 8 * dp), vv);
        float sc = 0.f;
#pragma unroll
        for (int e = 0; e < 8; ++e) sc += qv[e] * kv8[e];
        sc += __shfl_xor(sc, 1); sc += __shfl_xor(sc, 2); sc += __shfl_xor(sc, 4);
        sc = nok ? sc : -1e30f;
        dec_update(sc, vv, m, l, o);
    }
    float M = m;
    M = fmaxf(M, __shfl_xor(M, 8)); M = fmaxf(M, __shfl_xor(M, 16)); M = fmaxf(M, __shfl_xor(M, 32));
    const float f = __builtin_amdgcn_exp2f(m - M);
    l *= f;
    l += __shfl_xor(l, 8); l += __shfl_xor(l, 16); l += __shfl_xor(l, 32);
#pragma unroll
    for (int e = 0; e < 8; ++e) { float x = o[e] * f; x += __shfl_xor(x, 8); x += __shfl_xor(x, 16); x += __shfl_xor(x, 32); o[e] = x; }
    if (kq == 0) {
        const float inv = 1.0f / l;
        u32x4 w; w.x = pk2(o[0] * inv, o[1] * inv); w.y = pk2(o[2] * inv, o[3] * inv); w.z = pk2(o[4] * inv, o[5] * inv); w.w = pk2(o[6] * inv, o[7] * inv);
        *(u32x4*)(OP0 + row * 512 + h * 64 + 8 * dp) = w;
    }
}

__device__ __forceinline__ void sgu_unit(LAS unsigned char* lds, const bf16* UB, const bf16* VBB, const bf16* SW, const float* sgb, const float* gvp, const float* bvp, bf16* OAB, int chunk, int tid) {
    const int lane = tid & 63, wid = tid >> 6;
    const size_t R0 = (size_t)chunk * 128;
    {
        float gv8[8], bv8[8];
        { const f32x4 a = *(const f32x4*)(gvp + lane * 8), b2 = *(const f32x4*)(gvp + lane * 8 + 4), c = *(const f32x4*)(bvp + lane * 8), d = *(const f32x4*)(bvp + lane * 8 + 4);
#pragma unroll
          for (int e = 0; e < 4; ++e) { gv8[e] = a[e]; gv8[4 + e] = b2[e]; bv8[e] = c[e]; bv8[4 + e] = d[e]; } }
#pragma unroll 4
        for (int jj = 0; jj < 16; ++jj) {
            const int j = wid * 16 + jj;
            const u32x4 w = *(const u32x4*)(VBB + (R0 + j) * 512 + lane * 8); float v[8]; unpack8(w, v);
            float s = 0.f;
#pragma unroll
            for (int e = 0; e < 8; ++e) s += v[e];
            const float mean = wave_sum(s) * (1.0f / 512.0f); float qq = 0.f;
#pragma unroll
            for (int e = 0; e < 8; ++e) { v[e] -= mean; qq += v[e] * v[e]; }
            const float rstd = 1.0f / sqrtf(wave_sum(qq) * (1.0f / 512.0f) + LN_EPS);
#pragma unroll
            for (int e = 0; e < 8; ++e) v[e] = v[e] * rstd * gv8[e] + bv8[e];
            u32x4 o; o.x = pk2(v[0], v[1]); o.y = pk2(v[2], v[3]); o.z = pk2(v[4], v[5]); o.w = pk2(v[6], v[7]);
            *(LAS u32x4*)(lds + j * 1024 + ((lane ^ ((j & 3) << 2)) << 4)) = o;
        }
    }
    __syncthreads();
    const int it = wid & 3, cp = wid >> 2, il = lane & 31, hh = lane >> 5;
    const int i = 32 * it + il; const size_t row = R0 + i;
    const int qq = (lane & 15) >> 2;
    float ss = 0.f;
    for (int gi = 0; gi < 4; ++gi) {
        f32x16 acc[2];
#pragma unroll
        for (int c2 = 0; c2 < 2; ++c2)
#pragma unroll
            for (int x = 0; x < 16; ++x) acc[c2][x] = 0.f;
        for (int ks = 0; ks <= 2 * it + 1; ++ks) {
            const bf16x8 wf = *(const bf16x8*)(SW + ((size_t)(gi * 128 + 32 * it + il)) * 128 + 16 * ks + 8 * hh);
#pragma unroll
            for (int c2 = 0; c2 < 2; ++c2) {
                const int ch = (gi * 16 + (2 * cp + c2) * 4 + 2 * ((lane >> 4) & 1) + ((lane & 3) >> 1)) ^ (qq << 2);
                LAS unsigned char* ap = lds + (16 * ks + 8 * hh + qq) * 1024 + (ch << 4) + 8 * (lane & 1);
                const s16x4 va = tr_read(ap), vb = tr_read(ap + 4 * 1024);
                const bf16x8 af = (bf16x8){va[0], va[1], va[2], va[3], vb[0], vb[1], vb[2], vb[3]};
                acc[c2] = __builtin_amdgcn_mfma_f32_32x32x16_bf16(af, wf, acc[c2], 0, 0, 0);
            }
        }
        __syncthreads();
        const float bias = sgb[gi * 128 + i];
#pragma unroll
        for (int c2 = 0; c2 < 2; ++c2)
#pragma unroll
            for (int g4 = 0; g4 < 4; ++g4) {
                const int cl = (2 * cp + c2) * 32 + 8 * g4 + 4 * hh;
                const u32x2 uw = *(const u32x2*)(UB + row * 512 + gi * 128 + cl);
                const float x0 = bflo(uw.x) * (acc[c2][4 * g4 + 0] + bias), x1 = bfhi(uw.x) * (acc[c2][4 * g4 + 1] + bias), x2 = bflo(uw.y) * (acc[c2][4 * g4 + 2] + bias), x3 = bfhi(uw.y) * (acc[c2][4 * g4 + 3] + bias);
                ss += (x0 * x0 + x1 * x1) + (x2 * x2 + x3 * x3);
                u32x2 w; w.x = pk2(x0, x1); w.y = pk2(x2, x3);
                const int ch = (gi * 16 + (2 * cp + c2) * 4 + g4) ^ ((i & 3) << 2);
                *(LAS u32x2*)(lds + i * 1024 + (ch << 4) + 8 * hh) = w;
            }
    }
    ss += __shfl_xor(ss, 32);
    LAS float* ex = (LAS float*)(lds + EX_OFF);
    if (hh == 0) ex[wid * 32 + il] = ss;
    __syncthreads();
    {
        const int i2 = tid >> 2, gq = tid & 3;
        const float tot = ex[(i2 >> 5) * 32 + (i2 & 31)] + ex[((i2 >> 5) + 4) * 32 + (i2 & 31)];
        const float rr = 1.0f / sqrtf(tot * (1.0f / 512.0f) + LN_EPS);
        bf16* orow = OAB + (R0 + i2) * 1024 + 512 + gq * 128;
#pragma unroll
        for (int c8 = 0; c8 < 16; ++c8) {
            const u32x4 w = *(const LAS u32x4*)(lds + i2 * 1024 + (((gq * 16 + c8) ^ ((i2 & 3) << 2)) << 4)); float v[8]; unpack8(w, v);
            u32x4 o; o.x = pk2(v[0] * rr, v[1] * rr); o.y = pk2(v[2] * rr, v[3] * rr); o.z = pk2(v[4] * rr, v[5] * rr); o.w = pk2(v[6] * rr, v[7] * rr);
            *(u32x4*)(orow + c8 * 8) = o;
        }
    }
    __syncthreads();
}

__device__ __forceinline__ void sgu_sample(const bf16* UB, const bf16* VBB, const float* sgw, const float* sgb, const float* gvp, const float* bvp, bf16* OAB, float* out_sgv, int b, int lane) {
    float gv8[8], bv8[8];
    { const f32x4 a = *(const f32x4*)(gvp + lane * 8), b2 = *(const f32x4*)(gvp + lane * 8 + 4), c = *(const f32x4*)(bvp + lane * 8), d = *(const f32x4*)(bvp + lane * 8 + 4);
#pragma unroll
      for (int e = 0; e < 4; ++e) { gv8[e] = a[e]; gv8[4 + e] = b2[e]; bv8[e] = c[e]; bv8[4 + e] = d[e]; } }
    float vn[4][8];
#pragma unroll
    for (int t = 0; t < 4; ++t) {
        const size_t row = (size_t)MP + 4 * b + t;
        const u32x4 w = *(const u32x4*)(VBB + row * 512 + lane * 8); float v[8]; unpack8(w, v);
        float s = 0.f;
#pragma unroll
        for (int e = 0; e < 8; ++e) s += v[e];
        const float mean = wave_sum(s) * (1.0f / 512.0f); float qq = 0.f;
#pragma unroll
        for (int e = 0; e < 8; ++e) { v[e] -= mean; qq += v[e] * v[e]; }
        const float rstd = 1.0f / sqrtf(wave_sum(qq) * (1.0f / 512.0f) + LN_EPS);
#pragma unroll
        for (int e = 0; e < 8; ++e) vn[t][e] = v[e] * rstd * gv8[e] + bv8[e];
        float* op = out_sgv + ((size_t)b * 4 + t) * 512 + lane * 8;
        *(f32x4*)op = (f32x4){vn[t][0], vn[t][1], vn[t][2], vn[t][3]}; *(f32x4*)(op + 4) = (f32x4){vn[t][4], vn[t][5], vn[t][6], vn[t][7]};
    }
    const int gi = lane >> 4;
#pragma unroll
    for (int i = 0; i < 4; ++i) {
        const size_t row = (size_t)MP + 4 * b + i;
        const float bias = sgb[gi * 128 + i];
        float mix[8];
#pragma unroll
        for (int e = 0; e < 8; ++e) mix[e] = bias;
#pragma unroll
        for (int j = 0; j <= i; ++j) { const float wij = sgw[(size_t)(gi * 128 + i) * 128 + j];
#pragma unroll
            for (int e = 0; e < 8; ++e) mix[e] += wij * vn[j][e]; }
        const u32x4 uw = *(const u32x4*)(UB + row * 512 + lane * 8); float u[8]; unpack8(uw, u);
        float ss = 0.f;
#pragma unroll
        for (int e = 0; e < 8; ++e) { mix[e] *= u[e]; ss += mix[e] * mix[e]; }
        const float rr = 1.0f / sqrtf(wave_sum(ss) * (1.0f / 512.0f) + LN_EPS);
        u32x4 o; o.x = pk2(mix[0] * rr, mix[1] * rr); o.y = pk2(mix[2] * rr, mix[3] * rr); o.z = pk2(mix[4] * rr, mix[5] * rr); o.w = pk2(mix[6] * rr, mix[7] * rr);
        *(u32x4*)(OAB + row * 1024 + 512 + lane * 8) = o;
    }
}

struct CombIn { u32x4 a, b, c; float l0, l1, l2; };
__device__ __forceinline__ void combine_load(CombIn& I, const bf16* OP, const float* LSE, size_t row, int lane) {
    I.a = *(const u32x4*)(OP + row * 512 + lane * 8);
    if (row < (size_t)MP) {
        const int head = lane >> 3;
        I.l0 = LSE[row * 8 + head]; I.l1 = LSE[((size_t)M + row) * 8 + head]; I.l2 = LSE[((size_t)2 * M + row) * 8 + head];
        I.b = *(const u32x4*)(OP + ((size_t)M + row) * 512 + lane * 8); I.c = *(const u32x4*)(OP + ((size_t)2 * M + row) * 512 + lane * 8);
    }
}
__device__ __forceinline__ void combine_finish(const CombIn& I, bf16* OAB, size_t row, int lane) {
    float o[8];
    if (row < (size_t)MP) {
        const float mx = fmaxf(I.l0, fmaxf(I.l1, I.l2));
        float w0 = __builtin_amdgcn_exp2f(I.l0 - mx), w1 = __builtin_amdgcn_exp2f(I.l1 - mx), w2 = __builtin_amdgcn_exp2f(I.l2 - mx);
        const float inv = 1.0f / (w0 + w1 + w2); w0 *= inv; w1 *= inv; w2 *= inv;
        float a[8], b2[8], c[8];
        unpack8(I.a, a); unpack8(I.b, b2); unpack8(I.c, c);
#pragma unroll
        for (int e = 0; e < 8; ++e) o[e] = w0 * a[e] + w1 * b2[e] + w2 * c[e];
    } else unpack8(I.a, o);
    float ss = 0.f;
#pragma unroll
    for (int e = 0; e < 8; ++e) ss += o[e] * o[e];
    const float rr = 1.0f / sqrtf(wave_sum(ss) * (1.0f / 512.0f) + LN_EPS);
    u32x4 w; w.x = pk2(o[0] * rr, o[1] * rr); w.y = pk2(o[2] * rr, o[3] * rr); w.z = pk2(o[4] * rr, o[5] * rr); w.w = pk2(o[6] * rr, o[7] * rr);
    *(u32x4*)(OAB + row * 1024 + lane * 8) = w;
}
struct LnIn { u32x2 w[4]; };
__device__ __forceinline__ void final_ln_load(LnIn& I, const bf16* zrow, int lane) {
#pragma unroll
    for (int j = 0; j < 4; ++j) I.w[j] = *(const u32x2*)(zrow + 4 * lane + 256 * j);
}
__device__ __forceinline__ void final_ln_finish(const LnIn& I, float* y, const float* g, const float* bvec, int lane) {
    f32x4 v[4]; float s = 0.f;
#pragma unroll
    for (int j = 0; j < 4; ++j) { v[j] = (f32x4){bflo(I.w[j].x), bfhi(I.w[j].x), bflo(I.w[j].y), bfhi(I.w[j].y)}; s += (v[j][0] + v[j][1]) + (v[j][2] + v[j][3]); }
    const float mean = wave_sum(s) * (1.0f / 1024.0f); float qq = 0.f;
#pragma unroll
    for (int j = 0; j < 4; ++j) { v[j] = v[j] - mean; qq += (v[j][0] * v[j][0] + v[j][1] * v[j][1]) + (v[j][2] * v[j][2] + v[j][3] * v[j][3]); }
    const float rstd = 1.0f / sqrtf(wave_sum(qq) * (1.0f / 1024.0f) + LN_EPS);
#pragma unroll
    for (int j = 0; j < 4; ++j) { const f32x4 gg = *(const f32x4*)(g + 4 * lane + 256 * j), bb = *(const f32x4*)(bvec + 4 * lane + 256 * j); __builtin_nontemporal_store(v[j] * rstd * gg + bb, (f32x4*)(y + 4 * lane + 256 * j)); }
}

template <int MODE, bool STATS, bool ATILE>
__device__ __forceinline__ void small_res_unit(LAS unsigned char* lds, const bf16* A, const bf16* Bt, int K, int rb, int cb, const bf16* rsrc, const float* stprev, const float* g, const float* bvec, bf16* zb, float* stout, float scale, int tid_in) {
    int tid = tid_in; asm volatile("" : "+v"(tid));
    const int lane = tid & 63, wid = tid >> 6, fr = lane & 15, fq = lane >> 4;
    const int row0 = MP + rb * 32, col0 = cb * 64;
    const int kw = K >> 3, nks = kw >> 5;
    const bf16* ap = ATILE ? A + (size_t)(row0 >> 8) * ((size_t)256 * K) + (size_t)((row0 & 255) + fr) * 64 + 8 * fq : A + (size_t)(row0 + fr) * K + wid * kw + 8 * fq;
    const bf16* bp = Bt + (size_t)(col0 >> 8) * ((size_t)256 * K) + (size_t)((col0 & 255) + fr) * 64 + 8 * fq;
    f32x4 acc[2][4];
#pragma unroll
    for (int mt = 0; mt < 2; ++mt)
#pragma unroll
        for (int nt = 0; nt < 4; ++nt) acc[mt][nt] = (f32x4){0.f, 0.f, 0.f, 0.f};
#pragma unroll 2
    for (int ks = 0; ks < nks; ++ks) {
        bf16x8 af[2], bfr[4];
#pragma unroll
        for (int mt = 0; mt < 2; ++mt) { const int kc = wid * kw + ks * 32; af[mt] = ATILE ? *(const bf16x8*)(ap + (size_t)(kc >> 6) * (256 * 64) + mt * 16 * 64 + (kc & 63)) : *(const bf16x8*)(ap + (size_t)mt * 16 * K + ks * 32); }
#pragma unroll
        for (int nt = 0; nt < 4; ++nt) { const int kc = wid * kw + ks * 32; bfr[nt] = *(const bf16x8*)(bp + (size_t)(kc >> 6) * (256 * 64) + nt * 16 * 64 + (kc & 63)); }
#pragma unroll
        for (int mt = 0; mt < 2; ++mt)
#pragma unroll
            for (int nt = 0; nt < 4; ++nt) acc[mt][nt] = __builtin_amdgcn_mfma_f32_16x16x32_bf16(bfr[nt], af[mt], acc[mt][nt], 0, 0, 0);
    }
#pragma unroll
    for (int mt = 0; mt < 2; ++mt)
#pragma unroll
        for (int nt = 0; nt < 4; ++nt) *(LAS f32x4*)(lds + wid * 8192 + ((16 * mt + fr) * 64 + 16 * nt + 4 * fq) * 4) = acc[mt][nt];
    __syncthreads();
    const int tok = tid >> 4, n4 = (tid & 15) * 4;
    f32x4 v = *(const LAS f32x4*)(lds + (tok * 64 + n4) * 4);
#pragma unroll
    for (int w = 1; w < 8; ++w) v = v + *(const LAS f32x4*)(lds + w * 8192 + (tok * 64 + n4) * 4);
    const size_t row = (size_t)row0 + tok; const int col = col0 + n4;
    const u32x2 rw = *(const u32x2*)(rsrc + row * 1024 + col);
    f32x4 r = (f32x4){bflo(rw.x), bfhi(rw.x), bflo(rw.y), bfhi(rw.y)};
    if (MODE == 1) { float mean, rstd; pg8::combine16(stprev + row * 32, mean, rstd); r = (r - mean) * rstd * *(const f32x4*)(g + col) + *(const f32x4*)(bvec + col); }
    const f32x4 z = r * pg8::DN_ALPHA + v * scale;
    if (STATS) {
        float s = (z[0] + z[1]) + (z[2] + z[3]);
        s += __shfl_xor(s, 1); s += __shfl_xor(s, 2); s += __shfl_xor(s, 4); s += __shfl_xor(s, 8);
        const float mw = s * (1.0f / 64.0f); const f32x4 d = z - mw;
        float q = (d[0] * d[0] + d[1] * d[1]) + (d[2] * d[2] + d[3] * d[3]);
        q += __shfl_xor(q, 1); q += __shfl_xor(q, 2); q += __shfl_xor(q, 4); q += __shfl_xor(q, 8);
        if ((tid & 15) == 0) *(f32x2*)(stout + row * 32 + cb * 2) = (f32x2){mw, q};
    }
    u32x2 w; w.x = pk2(z[0], z[1]); w.y = pk2(z[2], z[3]);
    *(u32x2*)(zb + row * 1024 + col) = w;
    __syncthreads();
}
struct Args { const float* in[22]; float* out; unsigned char* ws; };
typedef const __attribute__((address_space(4))) unsigned char* karg_ptr;
__device__ __forceinline__ const float* karg_in(int k) { karg_ptr kp = (karg_ptr)__builtin_amdgcn_kernarg_segment_ptr(); asm volatile("" : "+s"(kp)); return *(const float* const __attribute__((address_space(4)))*)(kp + 8 * k); }
__device__ __forceinline__ float* karg_out() { karg_ptr kp = (karg_ptr)__builtin_amdgcn_kernarg_segment_ptr(); asm volatile("" : "+s"(kp)); return *(float* const __attribute__((address_space(4)))*)(kp + 176); }
__device__ __forceinline__ unsigned char* karg_ws() { karg_ptr kp = (karg_ptr)__builtin_amdgcn_kernarg_segment_ptr(); asm volatile("" : "+s"(kp)); return *(unsigned char* const __attribute__((address_space(4)))*)(kp + 184); }
static_assert(sizeof(Args) == 192, "Args layout");
template <int R> struct CopyHook {
    static constexpr int EXTRA = 2 * R;
    const float* src; float* dst; float* sink; int row, row_end, pr0, pr1; unsigned off; LAS unsigned char* stg; int wid;
    __device__ __forceinline__ void init(const float* ck, const float* cv, float* out, float* sink_, LAS unsigned char* stg_, int seg, int r0, int r1, int tid) {
        const int which = seg >> 7, b = seg & 127;
        src = (which ? cv : ck) + (size_t)b * WBUF * 512 + 2048; dst = out + (which ? OUT_CVS : OUT_CKS) + (size_t)b * WBUF * 512; sink = sink_; stg = stg_; row = r0; row_end = r1; off = (unsigned)tid * 4u; pr0 = r0; pr1 = r0;
        wid = __builtin_amdgcn_readfirstlane(tid >> 6);
    }
    __device__ __forceinline__ void prime() {
        *(f32x4*)(sink + off) = (f32x4){0.f, 0.f, 0.f, 0.f}; if (R == 2) *(f32x4*)(sink + 2048 + off) = (f32x4){0.f, 0.f, 0.f, 0.f};
    }
    __device__ __forceinline__ void ld() {
        pr0 = row < row_end - 1 ? row : row_end - 1; pr1 = row + 1 < row_end - 1 ? row + 1 : row_end - 1; row += R;
        __builtin_amdgcn_global_load_lds((const unsigned*)(src + (size_t)pr0 * 2048 + off), (LAS unsigned*)(stg + wid * 1024), 16, 0, 2);
        if (R == 2) __builtin_amdgcn_global_load_lds((const unsigned*)(src + (size_t)pr1 * 2048 + off), (LAS unsigned*)(stg + 8192 + wid * 1024), 16, 0, 2);
    }
    f32x4 d0, d1;
    __device__ __forceinline__ void rd() {
        d0 = *(const LAS f32x4*)(stg + off * 4u); if (R == 2) d1 = *(const LAS f32x4*)(stg + 8192 + off * 4u);
    }
    __device__ __forceinline__ void wr() {
        __builtin_nontemporal_store(d0, (f32x4*)(dst + (size_t)pr0 * 2048 + off)); if (R == 2) __builtin_nontemporal_store(d1, (f32x4*)(dst + (size_t)pr1 * 2048 + off));
    }
    __device__ __forceinline__ void flush() {
        for (int r = row; r < row_end; ++r) __builtin_nontemporal_store(__builtin_nontemporal_load((const f32x4*)(src + (size_t)r * 2048 + off)), (f32x4*)(dst + (size_t)r * 2048 + off));
    }
};
constexpr int COPY_ROWS = 511, COPY_R1 = 92, COPY_P3 = 202, COPY_P5 = 289, COPY_P6 = 353, COPY_P7 = 445, COPY_P7B = 467;
#ifndef REP_MASK
#define REP_MASK 0
#endif
#define REPS(n) (1 + ((REP_MASK >> (n)) & 1))
#define WSP(T, off) ((T*)(karg_ws() + (off)))
__global__ void __launch_bounds__(NTHREADS, 2) hymba_fwd(Args args_unused) {
    extern __shared__ __attribute__((aligned(16))) unsigned char lds_raw[];
    LAS unsigned char* lds = (LAS unsigned char*)lds_raw;
    const int tid = threadIdx.x, lane = tid & 63, wave = __builtin_amdgcn_readfirstlane(tid >> 6);
    const int G = gridDim.x; const int bx = blockIdx.x;
    const int vcu = (G % 8 == 0) ? (bx % 8) * (G / 8) + bx / 8 : bx;
    volatile LAS unsigned* MISC = (volatile LAS unsigned*)(lds + MISC_OFF);
    if (tid < 64) MISC[tid] = 0u;
    __syncthreads();
    XcdBarrier bar = xcd_barrier_post(WSP(unsigned, WS_CTL) + CW_BAR, MISC + 8);
#define GRID_BAR() do { XcdBarrier b_ = bar; b_.bar = WSP(unsigned, WS_CTL) + CW_BAR; xcd_barrier(b_); } while (0)
    const int gw = vcu * NWAVES + wave, NGW = G * NWAVES;
    constexpr size_t QS = (size_t)M * 512;

    for (int rep = 0; rep < REPS(0); ++rep) {
        if (rep) GRID_BAR();
        P0Args a; a.xp = karg_in(0); a.xs = karg_in(1); a.ck = karg_in(2); a.cv = karg_in(3); a.w1in = karg_in(4); a.w1out = karg_in(5); a.ln1g = karg_in(6); a.ln1b = karg_in(7); a.win = karg_in(8); a.sguw = karg_in(9);
        a.oag = karg_in(13); a.obg = karg_in(14); a.wout = karg_in(15); a.ln2g = karg_in(16); a.ln2b = karg_in(17); a.w2in = karg_in(18); a.w2out = karg_in(19);
        a.W1F8 = WSP(bf16, WS_W1F8); a.W2I8 = WSP(bf16, WS_W1IN); a.W1IN = nullptr; a.XF8 = WSP(unsigned char, WS_XF8); a.W1O8 = WSP(bf16, WS_W1O8); a.W2O8 = WSP(bf16, WS_W2O8); a.XS = WSP(float, WS_XS); a.W1OUT = WSP(bf16, WS_W1OUT); a.WIN = WSP(bf16, WS_WIN); a.WOUT = WSP(bf16, WS_WOUT); a.W2IN = WSP(bf16, WS_W2IN); a.W2OUT = WSP(bf16, WS_W2OUT);
        a.SGUW = WSP(bf16, WS_SGUW); a.XB = WSP(bf16, WS_XB); a.VECP = WSP(float, WS_VECP); a.out = karg_out();
        p0_prologue(a, lds, vcu, G, tid);
    }
    GRID_BAR();
    for (int rep = 0; rep < REPS(1); ++rep) {
        if (rep) GRID_BAR();
        vec_reduce(WSP(float, WS_VECP), WSP(float, WS_VEC), vcu * NTHREADS + tid, G * NTHREADS);
#ifndef F8P1
#define F8P1 24
#endif
#ifndef F8P
#define F8P 16
#endif
        {
            pg8::EpiSwiGLU<false, true> E{WSP(bf16, WS_H), nullptr, nullptr, nullptr, WSP(unsigned char, WS_H8), F8P1, WSP(float, WS_XS), WSP(float, WS_XS) + M};
            pg8::Gemm g{WSP(bf16, WS_XF8), WSP(bf16, WS_W1F8), M, NFF2, DM / 2, 1, 1}; pg8::StaticOrder S; S.init(M, NFF2, G, bx);
            CopyHook<1> hk; hk.init(karg_in(2), karg_in(3), karg_out(), WSP(float, WS_CTL + 512 * 1024), lds + CPY_OFF, bx, 0, COPY_R1, tid);
            pg8::gemm_phase<pg8::EpiSwiGLU<false, true>, pg8::StaticOrder, true, true, CopyHook<1>, 2>(lds, g, S, E, hk);
        }
    }
    GRID_BAR();
    for (int rep = 0; rep < REPS(2); ++rep) {
        if (rep) GRID_BAR();
        pg8::EpiRes<2, true> E{(const bf16*)karg_in(0), nullptr, nullptr, nullptr, WSP(bf16, WS_ZB), WSP(float, WS_ST1), 0.5f};
        constexpr int T8 = (F8P1 * 8 * 4 / 256) * 11, T16 = ((32 - F8P1) * 8 * 4 / 256) * 22;
        {
            pg8::Gemm g{WSP(bf16, WS_H8), WSP(bf16, WS_W1O8), MP, DM, DFF / 2, 1, 1}; pg8::RangeOrder<0, F8P1> S; S.init_sub(DM, G, bx);
            CopyHook<2> hk; hk.init(karg_in(2), karg_in(3), karg_out(), WSP(float, WS_CTL + 512 * 1024), lds + CPY_OFF, bx, COPY_R1, COPY_R1 + 2 * T8, tid);
            pg8::gemm_phase<pg8::EpiRes<2, true>, pg8::RangeOrder<0, F8P1>, true, true, CopyHook<2>, 1>(lds, g, S, E, hk);
        }
        {
            pg8::Gemm g{WSP(bf16, WS_H), WSP(bf16, WS_W1OUT), MP, DM, DFF, 1, 1}; pg8::RangeOrder<F8P1, 32> S; S.init_sub(DM, G, bx);
            CopyHook<2> hk; hk.init(karg_in(2), karg_in(3), karg_out(), WSP(float, WS_CTL + 512 * 1024), lds + CPY_OFF, bx, COPY_R1 + 2 * T8, COPY_R1 + 2 * T8 + 2 * T16, tid);
            pg8::gemm_phase<pg8::EpiRes<2, true>, pg8::RangeOrder<F8P1, 32>, true, true, CopyHook<2>, 0>(lds, g, S, E, hk);
        }
        for (int su = vcu; su < 256; su += G) small_res_unit<0, true, true>(lds, WSP(bf16, WS_H), WSP(bf16, WS_W1OUT), DFF, su >> 4, su & 15, WSP(bf16, WS_XB), nullptr, nullptr, nullptr, WSP(bf16, WS_ZB), WSP(float, WS_ST1), 0.5f, tid);
        if (G < 2 * DECB) {
            const float* ck = karg_in(2); const float* cv = karg_in(3); float* out = karg_out();
            for (int seg = bx + G; seg < 2 * DECB; seg += G) { CopyHook<1> h2; h2.init(ck, cv, out, nullptr, lds + CPY_OFF, seg, 0, COPY_ROWS, tid); h2.flush(); }
        }
    }
    GRID_BAR();
    {
        const float* st1 = WSP(float, WS_ST1); float* pr1 = WSP(float, WS_Z);
        for (int row = vcu * NTHREADS + tid; row < M; row += G * NTHREADS) { float mean, rstd; pg8::combine16(st1 + (size_t)row * 32, mean, rstd); pg8::f32x2v ab; ab.x = mean; ab.y = rstd; *(pg8::f32x2v*)(pr1 + 2 * (size_t)row) = ab; }
    }
    GRID_BAR();
    for (int rep = 0; rep < REPS(3); ++rep) {
        if (rep) GRID_BAR();
        pg8::Gemm g{WSP(bf16, WS_ZB), WSP(bf16, WS_WIN), M, NIN, DM, 0, 1}; pg8::StaticOrder S; S.init(M, NIN, G, bx);
        float* out = karg_out();
        pg8::EpiQKV E{WSP(bf16, WS_QKV), WSP(float, WS_Z), WSP(float, WS_VEC), WSP(float, WS_VEC) + NIN, out + OUT_CKP, out + OUT_CVP, out + OUT_CKS, out + OUT_CVS};
        CopyHook<1> hk; hk.init(karg_in(2), karg_in(3), out, WSP(float, WS_CTL + 512 * 1024), lds + CPY_OFF, bx, COPY_P3, COPY_P5, tid);
        pg8::gemm_phase<pg8::EpiQKV, pg8::StaticOrder, true, true, CopyHook<1> >(lds, g, S, E, hk);
    }
    GRID_BAR();
    for (int rep = 0; rep < REPS(4); ++rep) {
        if (rep) GRID_BAR();
        for (int r2 = 0; r2 < REPS(10); ++r2) {
            const bf16* QB = WSP(bf16, WS_QKV); bf16* OP = WSP(bf16, WS_H); float* LSE = WSP(float, WS_LSE);
#define ATT_DEC(u_, h_, b_, g_, dil_, r_, blk_) const int h_ = (u_) & 7, x_##u_ = (u_) >> 3, bl_##u_ = x_##u_ & 31, g_ = (x_##u_ >> 5) % 3, b_ = (x_##u_ >> 5) / 3; const int dil_ = 1 << (2 * g_), nb_##u_ = 32 / dil_, r_ = bl_##u_ / nb_##u_, blk_ = bl_##u_ % nb_##u_;
            constexpr int NU = NBATCH * 3 * 32 * NH;
            AttnKV R;
            if (vcu < NU) { const int u0 = vcu; ATT_DEC(u0, h0, b0, g0, dil0, r0, blk0) (void)g0; attn_issue(R, QB, QB + QS, QB + 2 * QS, b0, dil0, r0, blk0, h0, tid); }
            for (int u = vcu; u < NU; u += G) {
                ATT_DEC(u, h, b, g, dil, r, blk)
                attn_fill(lds, R, tid);
                const bf16x8 qcur[4] = {R.qf[0], R.qf[1], R.qf[2], R.qf[3]};
                __syncthreads();
                const int un = u + G;
                if (un < NU) { ATT_DEC(un, hn, bn, gn, diln, rn, blkn) (void)gn; attn_issue(R, QB, QB + QS, QB + 2 * QS, bn, diln, rn, blkn, hn, tid); }
                attn_compute(lds, qcur, OP + (size_t)g * QS, LSE + (size_t)g * M * 8, b, dil, r, blk, h, tid);
            }
#undef ATT_DEC
        }
        for (int r2 = 0; r2 < REPS(11); ++r2) {
            const bf16* QB = WSP(bf16, WS_QKV);
            for (int c = vcu; c < MP / 128; c += G) sgu_unit(lds, QB + 3 * QS, QB + 4 * QS, WSP(bf16, WS_SGUW), karg_in(10), karg_in(11), karg_in(12), WSP(bf16, WS_XB), c, tid);
        }
        for (int r2 = 0; r2 < REPS(12); ++r2) {
            const bf16* QB = WSP(bf16, WS_QKV);
            int ln = threadIdx.x & 63; asm volatile("" : "+v"(ln));
            for (int t = gw; t < DECB * NH * DECS; t += NGW) decode_task(QB, QB + QS, QB + 2 * QS, karg_in(2), karg_in(3), WSP(bf16, WS_H), t >> 5, (t >> 2) & 7, t & 3, ln);
            for (int b = gw; b < DECB; b += NGW) sgu_sample(QB + 3 * QS, QB + 4 * QS, karg_in(9), karg_in(10), karg_in(11), karg_in(12), WSP(bf16, WS_XB), karg_out() + OUT_SGV, b, ln);
        }
    }
    GRID_BAR();
    for (int rep = 0; rep < REPS(9); ++rep) {
        if (rep) GRID_BAR();
        const bf16* OP = WSP(bf16, WS_H); const float* LSE = WSP(float, WS_LSE); bf16* OAB = WSP(bf16, WS_XB);
        int lnb = threadIdx.x & 63; asm volatile("" : "+v"(lnb));
        for (size_t row = gw; row < (size_t)M; row += 4 * (size_t)NGW) {
            CombIn I[4];
#pragma unroll
            for (int q = 0; q < 4; ++q) { const size_t rq = row + (size_t)q * NGW; if (rq < (size_t)M) combine_load(I[q], OP, LSE, rq, lnb); }
#pragma unroll
            for (int q = 0; q < 4; ++q) { const size_t rq = row + (size_t)q * NGW; if (rq < (size_t)M) combine_finish(I[q], OAB, rq, lnb); }
        }
    }
    GRID_BAR();
    for (int rep = 0; rep < REPS(5); ++rep) {
        if (rep) GRID_BAR();
        pg8::Gemm g{WSP(bf16, WS_XB), WSP(bf16, WS_WOUT), MP, DM, DM, 0, 1}; pg8::StaticOrder S; S.init(MP, DM, G, bx);
        pg8::EpiRes<1, true> E{WSP(bf16, WS_ZB), WSP(float, WS_Z), karg_in(6), karg_in(7), WSP(bf16, WS_ZB), WSP(float, WS_ST2), 1.0f};
        CopyHook<2> hk; hk.init(karg_in(2), karg_in(3), karg_out(), WSP(float, WS_CTL + 512 * 1024), lds + CPY_OFF, bx, COPY_P5, COPY_P6, tid);
        pg8::gemm_phase<pg8::EpiRes<1, true>, pg8::StaticOrder, true, true, CopyHook<2> >(lds, g, S, E, hk);
        for (int su = vcu; su < 256; su += G) small_res_unit<1, true, false>(lds, WSP(bf16, WS_XB), WSP(bf16, WS_WOUT), DM, su >> 4, su & 15, WSP(bf16, WS_ZB), WSP(float, WS_ST1), karg_in(6), karg_in(7), WSP(bf16, WS_ZB), WSP(float, WS_ST2), 1.0f, tid);
    }
    GRID_BAR();
    for (int rep = 0; rep < REPS(9); ++rep) {
        if (rep) GRID_BAR();
        const bf16* zb = WSP(bf16, WS_ZB); unsigned char* zi = WSP(unsigned char, WS_XF8); float* zs = WSP(float, WS_XS) + M + 2 * NFF2; const float* st2 = WSP(float, WS_ST2); float* pr2 = WSP(float, WS_Z + MiB);
        int lnq = threadIdx.x & 63; asm volatile("" : "+v"(lnq));
        for (size_t row = gw; row < (size_t)M; row += 4 * (size_t)NGW) {
            u32x4 v[4][2];
#pragma unroll
            for (int q = 0; q < 4; ++q) { const size_t rq = row + (size_t)q * NGW; if (rq < (size_t)M) { v[q][0] = *(const u32x4*)(zb + rq * DM + 8 * lnq); v[q][1] = *(const u32x4*)(zb + rq * DM + 512 + 8 * lnq); } }
#pragma unroll
            for (int q = 0; q < 4; ++q) { const size_t rq = row + (size_t)q * NGW; if (rq < (size_t)M) {
                float f[2][8]; unpack8(v[q][0], f[0]); unpack8(v[q][1], f[1]);
                float mean, rstd; pg8::combine16(st2 + rq * 32, mean, rstd);
                float am = 0.f;
#pragma unroll
                for (int e = 0; e < 8; ++e) { f[0][e] = (f[0][e] - mean) * rstd; f[1][e] = (f[1][e] - mean) * rstd; am = fmaxf(am, fmaxf(fabsf(f[0][e]), fabsf(f[1][e]))); }
                am = wave_max(am);
                const float inv = am > 0.f ? 127.0f / am : 0.f;
                if (lnq == 0) { pg8::f32x2v ab; ab.x = am * (1.0f / 127.0f); ab.y = 0.f; *(pg8::f32x2v*)(zs + 2 * rq) = ab; ab.x = mean; ab.y = rstd; *(pg8::f32x2v*)(pr2 + 2 * rq) = ab; }
                unsigned char* dst = zi + (rq >> 8) * ((size_t)256 * DM) + (rq & 255) * 128 + (size_t)(lnq >> 4) * (256 * 128) + 8 * (lnq & 15);
#pragma unroll
                for (int h = 0; h < 2; ++h) { u32x2 o; o.x = pk4_i8(f[h][0] * inv, f[h][1] * inv, f[h][2] * inv, f[h][3] * inv); o.y = pk4_i8(f[h][4] * inv, f[h][5] * inv, f[h][6] * inv, f[h][7] * inv);
                    *(u32x2*)(dst + (size_t)h * (4 * 256 * 128)) = o; }
            } }
        }
    }
    GRID_BAR();
    for (int rep = 0; rep < REPS(6); ++rep) {
        if (rep) GRID_BAR();
        pg8::Gemm g{WSP(bf16, WS_XF8), WSP(bf16, WS_W1IN), M, NFF2, DM / 2, 1, 1}; pg8::StaticOrder S; S.init(M, NFF2, G, bx);
        pg8::EpiSwiGLU<true, true> E{WSP(bf16, WS_H), WSP(float, WS_ST2), WSP(float, WS_VEC) + 2 * NIN, WSP(float, WS_VEC) + 2 * NIN + NFF2, WSP(unsigned char, WS_H8), F8P, WSP(float, WS_XS) + M + 2 * NFF2, WSP(float, WS_XS) + M + NFF2};
        { CopyHook<1> hk; hk.init(karg_in(2), karg_in(3), karg_out(), WSP(float, WS_CTL + 512 * 1024), lds + CPY_OFF, bx, COPY_P6, COPY_P7, tid);
          pg8::gemm_phase<pg8::EpiSwiGLU<true, true>, pg8::StaticOrder, true, true, CopyHook<1>, 2>(lds, g, S, E, hk); }
    }
    GRID_BAR();
    for (int rep = 0; rep < REPS(7); ++rep) {
        if (rep) GRID_BAR();
        pg8::EpiRes<1, false> E{WSP(bf16, WS_ZB), WSP(float, WS_Z + MiB), karg_in(16), karg_in(17), WSP(bf16, WS_ZB), nullptr, 0.5f};
        constexpr int T8 = (F8P * 8 * 4 / 256) * 11;
        {
            pg8::Gemm g{WSP(bf16, WS_H8), WSP(bf16, WS_W2O8), MP, DM, DFF / 2, 1, 1}; pg8::RangeOrder<0, F8P> S; S.init_sub(DM, G, bx);
            CopyHook<1> hk; hk.init(karg_in(2), karg_in(3), karg_out(), WSP(float, WS_CTL + 512 * 1024), lds + CPY_OFF, bx, COPY_P7, COPY_P7B, tid);
            pg8::gemm_phase<pg8::EpiRes<1, false>, pg8::RangeOrder<0, F8P>, true, true, CopyHook<1>, 1>(lds, g, S, E, hk);
        }
        {
            pg8::Gemm g{WSP(bf16, WS_H), WSP(bf16, WS_W2OUT), MP, DM, DFF, 1, 1}; pg8::RangeOrder<F8P, 32> S; S.init_sub(DM, G, bx);
            CopyHook<1> hk; hk.init(karg_in(2), karg_in(3), karg_out(), WSP(float, WS_CTL + 512 * 1024), lds + CPY_OFF, bx, COPY_P7B, COPY_ROWS, tid);
            pg8::gemm_phase<pg8::EpiRes<1, false>, pg8::RangeOrder<F8P, 32>, true, true, CopyHook<1>, 0>(lds, g, S, E, hk);
        }
        for (int su = vcu; su < 256; su += G) small_res_unit<1, false, true>(lds, WSP(bf16, WS_H), WSP(bf16, WS_W2OUT), DFF, su >> 4, su & 15, WSP(bf16, WS_ZB), WSP(float, WS_ST2), karg_in(16), karg_in(17), WSP(bf16, WS_ZB), nullptr, 0.5f, tid);
    }
    GRID_BAR();
    for (int rep = 0; rep < REPS(8); ++rep) {
        if (rep) GRID_BAR();
        float* y = karg_out() + OUT_Y; const float* g3 = karg_in(20); const float* b3 = karg_in(21); const bf16* z3 = WSP(bf16, WS_ZB);
        int ln8 = threadIdx.x & 63; asm volatile("" : "+v"(ln8));
        for (size_t row = gw; row < (size_t)M; row += 4 * (size_t)NGW) {
            LnIn I[4];
#pragma unroll
            for (int q = 0; q < 4; ++q) { const size_t rq = row + (size_t)q * NGW; if (rq < (size_t)M) final_ln_load(I[q], z3 + rq * DM, ln8); }
#pragma unroll
            for (int q = 0; q < 4; ++q) { const size_t rq = row + (size_t)q * NGW; if (rq < (size_t)M) final_ln_finish(I[q], y + rq * DM, g3, b3, ln8); }
        }
    }
}

extern "C" void kernel_launch(void* const* d_in, const int* in_sizes, int n_in, void* d_out, int out_size, void* d_ws, size_t ws_size, hipStream_t stream) {
    static int grid = 0;
    if (grid == 0) {
        if (n_in != 22 || (size_t)out_size != OUT_TOTAL || ws_size < WS_END) { fprintf(stderr, "kernel_launch: unexpected shapes (n_in %d, out %d, ws %zu); nothing launched\n", n_in, out_size, ws_size); grid = -1; return; }
        int dev = 0, cus = 0;
        if (hipGetDevice(&dev) != hipSuccess || hipDeviceGetAttribute(&cus, hipDeviceAttributeMultiprocessorCount, dev) != hipSuccess || cus <= 0) { fprintf(stderr, "kernel_launch: device query failed\n"); grid = -1; return; }
        if (hipFuncSetAttribute((const void*)hymba_fwd, hipFuncAttributeMaxDynamicSharedMemorySize, LDS_BYTES) != hipSuccess) { fprintf(stderr, "kernel_launch: hipFuncSetAttribute failed\n"); grid = -1; return; }
        int per_cu = 0;
        if (hipOccupancyMaxActiveBlocksPerMultiprocessor(&per_cu, (const void*)hymba_fwd, NTHREADS, LDS_BYTES) != hipSuccess || per_cu < 1) { fprintf(stderr, "kernel_launch: occupancy query reports %d workgroups per CU\n", per_cu); }
        (void)hipGetLastError();
        grid = cus;
    }
    if (grid < 0) return;
    if (hipMemsetAsync((char*)d_ws + WS_CTL, 0, CTL_ZERO_BYTES, stream) != hipSuccess) { fprintf(stderr, "kernel_launch: memset failed\n"); return; }
    Args a{};
    for (int i = 0; i < 22; ++i) a.in[i] = (const float*)d_in[i];
    a.out = (float*)d_out; a.ws = (unsigned char*)d_ws;
    hipLaunchKernelGGL(hymba_fwd, dim3(grid), dim3(NTHREADS), LDS_BYTES, stream, a);
    const hipError_t le = hipPeekAtLastError();
    if (le != hipSuccess) fprintf(stderr, "kernel_launch: launch failed: %s\n", hipGetErrorName(le));
}
```
